# Optimizing an MI355X kernel written in HIP

```python
import math
import jax, jax.numpy as jnp
from jax import lax
import numpy as np

D_MODEL = 2048
BATCH = 16
SEQ = 2048
DEPTH = 1

GRID_W = 64
CTX_LEN = 256
D_SSM = 1024
GROUP_CH = 16
SSM_GROUPS = D_SSM // GROUP_CH
SSM_STATE = 64
N_DIR = 2
DT_MIN = 1e-3
DT_MAX = 1e-1
N_HEADS = 8
HEAD_DIM = 64
V_DIM = 2 * HEAD_DIM
D_QK = N_HEADS * 2 * HEAD_DIM
D_ATTN = N_HEADS * V_DIM
ATTN_SCALE = HEAD_DIM ** -0.5
ROPE_AXIS_DIM = HEAD_DIM // 2
ROPE_BASE = 10000.0
Q_BLOCK = 128
D_FF = ((8 * D_MODEL + 3 * 256 - 1) // (3 * 256)) * 256
D_IN = D_SSM + 2 * D_QK + D_ATTN + 2 * D_MODEL
IN_SPLITS = (D_SSM, D_SSM + D_QK, D_SSM + 2 * D_QK, D_SSM + 2 * D_QK + D_ATTN,
             D_SSM + 2 * D_QK + D_ATTN + D_MODEL)
EPS = 1e-6

kernel_name = "hybrid_s5_diffattn_dit_block"


def rms_norm(x, g):
    xf = x.astype(jnp.float32)
    y = xf * lax.rsqrt(jnp.mean(xf * xf, axis=-1, keepdims=True) + EPS)
    return (y * g.astype(jnp.float32)).astype(x.dtype)


def modulate(h, shift, scale):
    return h * (1.0 + scale) + shift


def axial_rope_tables(rows):
    row = jnp.repeat(jnp.arange(rows, dtype=jnp.float32), GRID_W)
    col = jnp.tile(jnp.arange(GRID_W, dtype=jnp.float32), rows)
    inv = 1.0 / (ROPE_BASE ** (jnp.arange(0, ROPE_AXIS_DIM, 2, dtype=jnp.float32) / ROPE_AXIS_DIM))
    ang_r = (row[:, None] * inv)[:, None, None, :]
    ang_c = (col[:, None] * inv)[:, None, None, :]
    return jnp.cos(ang_r), jnp.sin(ang_r), jnp.cos(ang_c), jnp.sin(ang_c)


def rope_half(x, cos, sin):
    x1, x2 = jnp.split(x, 2, axis=-1)
    return jnp.concatenate([x1 * cos - x2 * sin, x2 * cos + x1 * sin], axis=-1)


def apply_axial_rope(x, tables):
    cos_r, sin_r, cos_c, sin_c = tables
    xr, xc = jnp.split(x.astype(jnp.float32), 2, axis=-1)
    out = jnp.concatenate([rope_half(xr, cos_r, sin_r), rope_half(xc, cos_c, sin_c)], axis=-1)
    return out.astype(x.dtype)


def s5_discretise(a_re, a_im, log_dt, b_re, b_im):
    lam = lax.complex(a_re.astype(jnp.float32), a_im.astype(jnp.float32))
    dt = jnp.exp(log_dt.astype(jnp.float32))[:, None]
    lam_bar = jnp.exp(lam * dt)
    b = lax.complex(b_re.astype(jnp.float32), b_im.astype(jnp.float32))
    b_bar = ((lam_bar - 1.0) / lam)[..., None] * b
    return lam_bar, b_bar


def linear_scan(lam_bar, bu):
    a = jnp.broadcast_to(lam_bar, (1, bu.shape[1]) + lam_bar.shape)

    def combine(e1, e2):
        a1, b1 = e1
        a2, b2 = e2
        return a2 * a1, a2 * b1 + b2

    _, states = lax.associative_scan(combine, (a, bu), axis=1)
    return states


def s5_glu(y, w_glu, b_glu, dtype):
    z = jax.nn.gelu(y)
    return (z * jax.nn.sigmoid(z @ w_glu + b_glu)).astype(dtype)


def s5_branch(u_c, u_l, a_re, a_im, log_dt, b_re, b_im, c_re, c_im, d_skip, w_glu, b_glu, with_ctx):
    bsz, lc, _ = u_c.shape
    n_lat = u_l.shape[1]
    uc = u_c.astype(jnp.float32).reshape(bsz, lc, SSM_GROUPS, GROUP_CH)
    ul = u_l.astype(jnp.float32).reshape(bsz, n_lat, SSM_GROUPS, GROUP_CH)
    ys_c, ys_l = [], []
    for direction in range(N_DIR):
        rev = direction == 1
        lam_bar, b_bar = s5_discretise(a_re[direction], a_im[direction], log_dt[direction],
                                       b_re[direction], b_im[direction])
        c_mat = lax.complex(c_re[direction].astype(jnp.float32), c_im[direction].astype(jnp.float32))
        uc_d = jnp.flip(uc, axis=1) if rev else uc
        ul_d = jnp.flip(ul, axis=1) if rev else ul
        bu_c = jnp.einsum('blgc,gpc->blgp', uc_d.astype(jnp.complex64), b_bar)
        st_c = linear_scan(lam_bar, bu_c)
        bu_l = jnp.einsum('blgc,gpc->blgp', ul_d.astype(jnp.complex64), b_bar)
        bu_l = bu_l.at[:, 0].add(lam_bar * st_c[:, -1])
        st_l = linear_scan(lam_bar, bu_l)
        yl = jnp.real(jnp.einsum('blgp,gcp->blgc', st_l, c_mat))
        ys_l.append(jnp.flip(yl, axis=1) if rev else yl)
        if with_ctx:
            yc = jnp.real(jnp.einsum('blgp,gcp->blgc', st_c, c_mat))
            ys_c.append(jnp.flip(yc, axis=1) if rev else yc)
    d = d_skip.astype(jnp.float32).reshape(SSM_GROUPS, GROUP_CH)
    y_l = (ys_l[0] + ys_l[1] + d * ul).reshape(bsz, n_lat, D_SSM)
    y_l = s5_glu(y_l, w_glu, b_glu, u_l.dtype)
    y_c = None
    if with_ctx:
        y_c = (ys_c[0] + ys_c[1] + d * uc).reshape(bsz, lc, D_SSM)
        y_c = s5_glu(y_c, w_glu, b_glu, u_c.dtype)
    return y_c, y_l


def diff_attention(q, k, v, lam):
    s = jnp.einsum('bqhmd,bkhmd->bhmqk', q, k).astype(jnp.float32) * ATTN_SCALE
    p = jax.nn.softmax(s, axis=-1)
    p = p[:, :, 0] - lam * p[:, :, 1]
    return jnp.einsum('bhqk,bkhe->bqhe', p.astype(v.dtype), v)


def blocked_diff_attention(q, k, v, lam):
    bsz, n_lat, heads = q.shape[:3]
    nb = n_lat // Q_BLOCK
    qb = jnp.moveaxis(q.reshape(bsz, nb, Q_BLOCK, heads, 2, HEAD_DIM), 1, 0)
    ob = lax.map(lambda blk: diff_attention(blk, k, v, lam), qb)
    return jnp.moveaxis(ob, 0, 1).reshape(bsz, n_lat, heads, V_DIM)


def head_out(o, g, lam_init):
    return (rms_norm(o, g) * (1.0 - lam_init)).reshape(o.shape[0], o.shape[1], D_ATTN)


def branch_merge(y_ssm, o_attn, g_s, g_a, w_ps, w_pa, w_o):
    merged = jax.nn.sigmoid(g_s) * (y_ssm @ w_ps) + jax.nn.sigmoid(g_a) * (o_attn @ w_pa)
    return merged @ w_o


def swiglu(h, w_in, w_out):
    gate, up = jnp.split(h @ w_in, 2, axis=-1)
    return (jax.nn.silu(gate) * up) @ w_out


def setup_inputs(seed: int = 0) -> dict:
    key = jax.random.key(seed)
    ks = jax.random.split(key, 32)
    f32 = jnp.float32

    def nrm(k, shape, s):
        return jax.random.normal(k, shape, f32) * s

    ssm_shape = (DEPTH, N_DIR, SSM_GROUPS, SSM_STATE)
    return {
        "x": nrm(ks[0], (BATCH, SEQ, D_MODEL), 1.0),
        "c": nrm(ks[1], (BATCH, D_MODEL), 1.0),
        "ctx": nrm(ks[2], (BATCH, CTX_LEN, D_MODEL), 1.0),
        "c_ctx": nrm(ks[3], (D_MODEL,), 1.0),
        "w_ada": nrm(ks[4], (DEPTH, D_MODEL, 6 * D_MODEL), 0.5 * D_MODEL ** -0.5),
        "b_ada": nrm(ks[5], (DEPTH, 6 * D_MODEL), 0.02),
        "norm1_g": 1.0 + nrm(ks[6], (DEPTH, D_MODEL), 0.02),
        "w_in": nrm(ks[7], (DEPTH, D_MODEL, D_IN), D_MODEL ** -0.5),
        "ssm_a_re": -0.5 + nrm(ks[8], ssm_shape, 0.01),
        "ssm_a_im": jnp.pi * jnp.arange(SSM_STATE, dtype=f32) + nrm(ks[9], ssm_shape, 0.01),
        "ssm_log_dt": jax.random.uniform(ks[10], (DEPTH, N_DIR, SSM_GROUPS), f32,
                                         math.log(DT_MIN), math.log(DT_MAX)),
        "ssm_b_re": nrm(ks[11], ssm_shape + (GROUP_CH,), (2 * GROUP_CH) ** -0.5),
        "ssm_b_im": nrm(ks[12], ssm_shape + (GROUP_CH,), (2 * GROUP_CH) ** -0.5),
        "ssm_c_re": nrm(ks[13], (DEPTH, N_DIR, SSM_GROUPS, GROUP_CH, SSM_STATE), (2 * SSM_STATE) ** -0.5),
        "ssm_c_im": nrm(ks[14], (DEPTH, N_DIR, SSM_GROUPS, GROUP_CH, SSM_STATE), (2 * SSM_STATE) ** -0.5),
        "ssm_d": nrm(ks[15], (DEPTH, D_SSM), 1.0),
        "w_glu": nrm(ks[16], (DEPTH, D_SSM, D_SSM), D_SSM ** -0.5),
        "b_glu": nrm(ks[17], (DEPTH, D_SSM), 0.02),
        "lambda_q1": nrm(ks[18], (DEPTH, HEAD_DIM), 0.1),
        "lambda_k1": nrm(ks[19], (DEPTH, HEAD_DIM), 0.1),
        "lambda_q2": nrm(ks[20], (DEPTH, HEAD_DIM), 0.1),
        "lambda_k2": nrm(ks[21], (DEPTH, HEAD_DIM), 0.1),
        "subln_g": 1.0 + nrm(ks[22], (DEPTH, V_DIM), 0.02),
        "w_proj_ssm": nrm(ks[23], (DEPTH, D_SSM, D_MODEL), D_SSM ** -0.5),
        "w_proj_attn": nrm(ks[24], (DEPTH, D_ATTN, D_MODEL), D_ATTN ** -0.5),
        "w_out": nrm(ks[25], (DEPTH, D_MODEL, D_MODEL), D_MODEL ** -0.5),
        "norm2_g": 1.0 + nrm(ks[26], (DEPTH, D_MODEL), 0.02),
        "w_ffn_in": nrm(ks[27], (DEPTH, D_MODEL, 2 * D_FF), D_MODEL ** -0.5),
        "w_ffn_out": nrm(ks[28], (DEPTH, D_FF, D_MODEL), D_FF ** -0.5),
        "norm_f_g": 1.0 + nrm(ks[29], (D_MODEL,), 0.02),
    }


def reference(x, c, ctx, c_ctx, w_ada, b_ada, norm1_g, w_in, ssm_a_re, ssm_a_im, ssm_log_dt,
              ssm_b_re, ssm_b_im, ssm_c_re, ssm_c_im, ssm_d, w_glu, b_glu,
              lambda_q1, lambda_k1, lambda_q2, lambda_k2, subln_g,
              w_proj_ssm, w_proj_attn, w_out, norm2_g, w_ffn_in, w_ffn_out, norm_f_g):
    bsz, n_lat, _ = x.shape
    n_ctx = ctx.shape[1]
    rows = n_lat // GRID_W
    rope = axial_rope_tables(rows)
    silu_c = jax.nn.silu(c)
    silu_cc = jax.nn.silu(c_ctx)

    for li in range(DEPTH):
        with_ctx = li < DEPTH - 1
        lam_init = 0.8 - 0.6 * math.exp(-0.3 * li)
        mod = silu_c @ w_ada[li] + b_ada[li]
        mod_c = silu_cc @ w_ada[li] + b_ada[li]
        sh1, sc1, g1, sh2, sc2, g2 = jnp.split(mod[:, None, :], 6, axis=-1)
        sh1c, sc1c, g1c, sh2c, sc2c, g2c = jnp.split(mod_c, 6, axis=-1)

        h = modulate(rms_norm(x, norm1_g[li]), sh1, sc1)
        hc = modulate(rms_norm(ctx, norm1_g[li]), sh1c, sc1c)
        u, q, k, v, g_s, g_a = jnp.split(h @ w_in[li], IN_SPLITS, axis=-1)
        uc, qc, kc, vc, g_sc, g_ac = jnp.split(hc @ w_in[li], IN_SPLITS, axis=-1)

        y_ssm_c, y_ssm = s5_branch(uc, u, ssm_a_re[li], ssm_a_im[li], ssm_log_dt[li],
                                   ssm_b_re[li], ssm_b_im[li], ssm_c_re[li], ssm_c_im[li],
                                   ssm_d[li], w_glu[li], b_glu[li], with_ctx)

        lq1 = lambda_q1[li].astype(jnp.float32)
        lk1 = lambda_k1[li].astype(jnp.float32)
        lq2 = lambda_q2[li].astype(jnp.float32)
        lk2 = lambda_k2[li].astype(jnp.float32)
        lam = jnp.exp(jnp.sum(lq1 * lk1)) - jnp.exp(jnp.sum(lq2 * lk2)) + lam_init
        q = apply_axial_rope(q.reshape(bsz, n_lat, N_HEADS, 2, HEAD_DIM), rope)
        k = apply_axial_rope(k.reshape(bsz, n_lat, N_HEADS, 2, HEAD_DIM), rope)
        v = v.reshape(bsz, n_lat, N_HEADS, V_DIM)
        kc = kc.reshape(bsz, n_ctx, N_HEADS, 2, HEAD_DIM)
        vc = vc.reshape(bsz, n_ctx, N_HEADS, V_DIM)
        k_all = jnp.concatenate([k, kc], axis=1)
        v_all = jnp.concatenate([v, vc], axis=1)
        o = head_out(blocked_diff_attention(q, k_all, v_all, lam), subln_g[li], lam_init)

        x_mid = x + g1 * branch_merge(y_ssm, o, g_s, g_a, w_proj_ssm[li], w_proj_attn[li], w_out[li])

        if with_ctx:
            oc = diff_attention(qc.reshape(bsz, n_ctx, N_HEADS, 2, HEAD_DIM), kc, vc, lam)
            oc = head_out(oc, subln_g[li], lam_init)
            ctx = ctx + g1c * branch_merge(y_ssm_c, oc, g_sc, g_ac, w_proj_ssm[li],
                                           w_proj_attn[li], w_out[li])
            ctx = ctx + g2c * swiglu(modulate(rms_norm(ctx, norm2_g[li]), sh2c, sc2c),
                                     w_ffn_in[li], w_ffn_out[li])

        x = x_mid + g2 * swiglu(modulate(rms_norm(x_mid, norm2_g[li]), sh2, sc2),
                                w_ffn_in[li], w_ffn_out[li])

    return rms_norm(x, norm_f_g)
```

```cpp
#include <hip/hip_runtime.h>
#include <hip/hip_cooperative_groups.h>
#include <cstdio>
#include <cstdint>
namespace cg = cooperative_groups;

#define LAS __attribute__((address_space(3)))
#define DI __device__ __forceinline__
typedef unsigned short bf16_t;
typedef short bf16x8 __attribute__((ext_vector_type(8)));
typedef float f32x4 __attribute__((ext_vector_type(4)));
typedef float f32x16 __attribute__((ext_vector_type(16)));
typedef unsigned u32x4 __attribute__((ext_vector_type(4)));
typedef unsigned u32x2 __attribute__((ext_vector_type(2)));
typedef float f32x2_t __attribute__((ext_vector_type(2)));
typedef __bf16 bf16x2_t __attribute__((ext_vector_type(2)));

constexpr int DM = 2048, NB = 16, SEQ = 2048, LCTX = 256, MLAT = NB * SEQ, MCTX = NB * LCTX, MTOT = MLAT + MCTX;
constexpr int KVLEN = SEQ + LCTX;
constexpr int DFF = 5632, DIN = 8192, NMOD = 6 * DM;
constexpr int TCH = 32;
constexpr int UROWS_PAD = 1280, UK = 768;
constexpr float QSCALE = 0.125f * 1.4426950408889634f;
constexpr int NTHREADS = 512;
constexpr int LDS_BYTES = 147456;

constexpr size_t MiB = 1u << 20;
constexpr size_t WS_WIN = 0, WS_WGLU = 32 * MiB, WS_WPS = 34 * MiB, WS_WPA = 38 * MiB, WS_WOUT = 42 * MiB, WS_WFI = 50 * MiB, WS_WFO = 94 * MiB;
constexpr size_t WS_BT3 = 116 * MiB, WS_BT1 = 164 * MiB, WS_MOD = 180 * MiB, WS_ROPE = 181 * MiB, WS_LAMS = 181 * MiB + 16384, WS_LAMT = 181 * MiB + 32768;
constexpr size_t WS_H = 182 * MiB, WS_OATT = 182 * MiB, WS_YSSM = 246 * MiB, WS_H2 = 182 * MiB;
constexpr size_t WS_UG = 326 * MiB, WS_S = 446 * MiB, WS_VT = 526 * MiB, WS_TMP = 326 * MiB, WS_HID = 326 * MiB;
constexpr size_t WS_Q = 598 * MiB, WS_Z = 598 * MiB, WS_K = 662 * MiB, WS_MERGED = 598 * MiB;
constexpr size_t WS_SGS = 734 * MiB, WS_SGA = 862 * MiB, WS_CGU = 990 * MiB, WS_ROWSS = 991 * MiB, WS_END = 992 * MiB;

DI unsigned pk2(float lo, float hi) { f32x2_t v = {lo, hi}; bf16x2_t b = __builtin_convertvector(v, bf16x2_t); return __builtin_bit_cast(unsigned, b); }
DI u32x2 pk4(f32x4 v) { u32x2 r; r.x = pk2(v[0], v[1]); r.y = pk2(v[2], v[3]); return r; }
DI float bf2f(unsigned h) { return __uint_as_float(h << 16); }
DI f32x4 unpk4(u32x2 w) { f32x4 r; r[0] = bf2f(w.x & 0xffffu); r[1] = bf2f(w.x >> 16); r[2] = bf2f(w.y & 0xffffu); r[3] = bf2f(w.y >> 16); return r; }
DI bf16_t f2bf1(float f) { return (bf16_t)(pk2(f, 0.f) & 0xffffu); }
DI float sigmoidf_(float x) { return __builtin_amdgcn_rcpf(1.f + __expf(-x)); }
DI float wave_sum(float v) {
#pragma unroll
    for (int o = 1; o < 64; o <<= 1) v += __shfl_xor(v, o);
    return v;
}

namespace pg8 {
constexpr int BM = 256, BK = 64, HALF = 128, HTB = HALF * BK * 2, STAGE_BYTES = 8 * HTB, NXCD = 8, WGM = 8;
__host__ __device__ __forceinline__ int lds_byte(int r, int c) { const int st = (r >> 4) * 2 + (c >> 5), rr = r & 15, cc = c & 31, ob = rr * 64 + cc * 2; return st * 1024 + (ob ^ (((ob >> 9) & 1) << 5)); }
__host__ __device__ __forceinline__ int perm32(int rho) { const int n = rho >> 4, i = rho & 15; return 8 * (i >> 2) + 4 * n + (i & 3); }
__host__ __device__ __forceinline__ void stage_rc(int b, int& R, int& C) { const int st = b / 1024, sb = b % 1024, swz = sb ^ (((sb >> 9) & 1) << 5); R = (st >> 1) * 16 + swz / 64; C = (st & 1) * 32 + (swz % 64) / 2; }

struct Unit { int pm, pn, bz; };
struct Gemm { const bf16_t* A; const bf16_t* Bt; int lda, ldb, K; size_t sA, sB; };

struct StaticOrder {
    int nM, nN, nB, nwg, G, c;
    DI void init(int nM_, int nN_, int nB_, int G_, int c_) { nM = nM_; nN = nN_; nB = nB_; nwg = nM_ * nN_; G = G_; c = c_; }
    DI bool next(int i, Unit& u) const {
        const int tot = nwg * nB; const long L = (long)i * G + c; if (L >= tot) return false;
        int wg = (int)L; { const int q = tot / NXCD, r = tot % NXCD, xcd = wg % NXCD, off = wg / NXCD; wg = (xcd < r ? xcd * (q + 1) : r * (q + 1) + (xcd - r) * q) + off; }
        u.bz = wg / nwg; const int wgid = wg % nwg;
        const int nig = WGM * nN, gid = wgid / nig, fm = gid * WGM, gsz = (nM - fm) < WGM ? (nM - fm) : WGM;
        u.pm = fm + ((wgid % nig) % gsz); u.pn = (wgid % nig) / gsz; return true;
    }
};
struct CtxOrder {
    int G, c;
    DI bool next(int i, Unit& u) const {
        const int L = i * G + c; if (L >= 16 * 12) return false;
        u.bz = 0; u.pm = 128 + L / 12; const int j = L % 12; u.pn = j < 4 ? j : j + 4; return true;
    }
};

template <class Epi, class Sched>
DI void gemm_phase(LAS unsigned char* lds, const Gemm g, const Sched& S, const Epi& E) {
    const int tid = threadIdx.x, wid = __builtin_amdgcn_readfirstlane(tid >> 6), lane = tid & 63, wr = wid >> 2, wc = wid & 3, fr = lane & 15, fq = lane >> 4;
    const int K = g.K, nt = K / BK;
    unsigned voffA[2], voffB[2];
#pragma unroll
    for (int i = 0; i < 2; ++i) { int R, C; stage_rc(tid * 16 + i * 8192, R, C); const int Rb = (R & ~31) + perm32(R & 31); voffA[i] = (unsigned)(R * g.lda + C) * 2u; voffB[i] = (unsigned)(Rb * g.ldb + C) * 2u; }
    const size_t kstep = (size_t)(BK * 2);
    const size_t hsA = (size_t)HALF * g.lda * 2, hsB = (size_t)HALF * g.ldb * 2;
    const unsigned ldsw = (unsigned)wid * 1024u;
    const int aoff = lds_byte(wr * 64 + fr, fq * 8), boff = lds_byte(wc * 32 + fr, fq * 8);
#define PG8_SA(b, h) (((b) * 2 + (h)) * HTB)
#define PG8_SB(b, h) ((4 + (b) * 2 + (h)) * HTB)
#define PG8_STAGE(bufoff, gbase, voff) do { _Pragma("unroll") for (int _i = 0; _i < 2; ++_i) \
        __builtin_amdgcn_global_load_lds((const unsigned*)((const char*)(gbase) + (voff)[_i]), (LAS unsigned*)(lds + (bufoff) + ldsw + _i * 8192), 16, 0, 0); } while (0)
#define PG8_LDA(dst, b, h) do { _Pragma("unroll") for (int m = 0; m < 4; ++m) _Pragma("unroll") for (int k = 0; k < 2; ++k) dst[m][k] = *(const LAS bf16x8*)(lds + PG8_SA(b, h) + aoff + m * 2048 + k * 1024); } while (0)
#define PG8_LDB(dst, b, h) do { _Pragma("unroll") for (int n = 0; n < 2; ++n) _Pragma("unroll") for (int k = 0; k < 2; ++k) dst[n][k] = *(const LAS bf16x8*)(lds + PG8_SB(b, h) + boff + n * 2048 + k * 1024); } while (0)
#define PG8_MMA(ai, bj, At, Bt) do { __builtin_amdgcn_s_setprio(1); _Pragma("unroll") for (int m = 0; m < 4; ++m) _Pragma("unroll") for (int n = 0; n < 2; ++n) _Pragma("unroll") for (int k = 0; k < 2; ++k) \
        acc[ai][bj][m][n] = __builtin_amdgcn_mfma_f32_16x16x32_bf16(Bt[n][k], At[m][k], acc[ai][bj][m][n], 0, 0, 0); __builtin_amdgcn_s_setprio(0); } while (0)
#define PG8_WAIT_V(n) asm volatile("s_waitcnt vmcnt(" #n ")" ::: "memory")
#define PG8_WAIT_L(n) asm volatile("s_waitcnt lgkmcnt(" #n ")" ::: "memory")
#define PG8_BAR __builtin_amdgcn_s_barrier()
#define PG8_SCHED __builtin_amdgcn_sched_barrier(0)
#define PG8_UA(u) ((const char*)g.A + ((size_t)(u).bz * g.sA + (size_t)(u).pm * BM * g.lda) * 2)
#define PG8_UB(u) ((const char*)g.Bt + ((size_t)(u).bz * g.sB + (size_t)(u).pn * BM * g.ldb) * 2)
    Unit cur, nxt; int ui = 0;
    if (!S.next(0, cur)) return;
    f32x4 acc[2][2][4][2];
#pragma unroll
    for (int a = 0; a < 2; ++a)
#pragma unroll
        for (int b = 0; b < 2; ++b)
#pragma unroll
            for (int m = 0; m < 4; ++m)
#pragma unroll
                for (int n = 0; n < 2; ++n) acc[a][b][m][n] = (f32x4){0.f, 0.f, 0.f, 0.f};
    bf16x8 At[4][2], B0[2][2], B1[2][2];
    const char* cA = PG8_UA(cur); const char* cB = PG8_UB(cur);
    PG8_STAGE(PG8_SB(0, 0), cB, voffB); PG8_STAGE(PG8_SB(0, 1), cB + hsB, voffB); PG8_STAGE(PG8_SA(0, 0), cA, voffA); PG8_STAGE(PG8_SA(0, 1), cA + hsA, voffA);
    if (wr == 1) PG8_BAR;
    PG8_WAIT_V(2); PG8_BAR;
    PG8_STAGE(PG8_SB(1, 0), cB + kstep, voffB); PG8_STAGE(PG8_SA(1, 0), cA + kstep, voffA); PG8_STAGE(PG8_SB(1, 1), cB + hsB + kstep, voffB);
    PG8_WAIT_V(6); PG8_BAR;
    for (;;) {
        const bool has_next = S.next(ui + 1, nxt);
        const char* nA = has_next ? PG8_UA(nxt) : cA; const char* nB = has_next ? PG8_UB(nxt) : cB;
        for (int t = 0; t < nt; t += 2) {
            const bool last = (t == nt - 2);
            const char* a1 = cA + (size_t)(t + 1) * kstep;
            const char* a2 = last ? nA : cA + (size_t)(t + 2) * kstep; const char* b2 = last ? nB : cB + (size_t)(t + 2) * kstep;
            const char* a3 = a2 + kstep; const char* b3 = b2 + kstep;
            PG8_LDB(B0, 0, 0); PG8_LDB(B1, 0, 1); PG8_SCHED; PG8_LDA(At, 0, 0); PG8_STAGE(PG8_SA(1, 1), a1 + hsA, voffA);
            PG8_WAIT_V(8); PG8_WAIT_L(0); PG8_BAR; PG8_MMA(0, 0, At, B0); PG8_MMA(0, 1, At, B1); PG8_BAR; PG8_SCHED;
            PG8_LDA(At, 0, 1); PG8_STAGE(PG8_SB(0, 0), b2, voffB); PG8_STAGE(PG8_SB(0, 1), b2 + hsB, voffB); PG8_STAGE(PG8_SA(0, 0), a2, voffA);
            PG8_WAIT_V(8); PG8_WAIT_L(0); PG8_BAR; PG8_MMA(1, 0, At, B0); PG8_MMA(1, 1, At, B1); PG8_BAR; PG8_SCHED;
            PG8_LDB(B0, 1, 0); PG8_LDB(B1, 1, 1); PG8_SCHED; PG8_LDA(At, 1, 0); PG8_STAGE(PG8_SA(0, 1), a2 + hsA, voffA);
            PG8_WAIT_V(8); PG8_WAIT_L(0); PG8_BAR; PG8_MMA(0, 0, At, B0); PG8_MMA(0, 1, At, B1); PG8_BAR; PG8_SCHED;
            PG8_LDA(At, 1, 1); PG8_STAGE(PG8_SB(1, 0), b3, voffB); PG8_STAGE(PG8_SB(1, 1), b3 + hsB, voffB); PG8_STAGE(PG8_SA(1, 0), a3, voffA);
            PG8_WAIT_V(8); PG8_WAIT_L(0); PG8_BAR; PG8_MMA(1, 0, At, B0); PG8_MMA(1, 1, At, B1); PG8_BAR; PG8_SCHED;
        }
        if (wr == 0) PG8_BAR;
        E(acc, cur, wr, wc, fr, fq);
        if (!has_next) break;
#pragma unroll
        for (int a = 0; a < 2; ++a)
#pragma unroll
            for (int b = 0; b < 2; ++b)
#pragma unroll
                for (int m = 0; m < 4; ++m)
#pragma unroll
                    for (int n = 0; n < 2; ++n) acc[a][b][m][n] = (f32x4){0.f, 0.f, 0.f, 0.f};
        cur = nxt; cA = nA; cB = nB; ++ui;
        if (wr == 1) PG8_BAR;
    }
    PG8_WAIT_V(0);
    PG8_BAR;
#undef PG8_SA
#undef PG8_SB
#undef PG8_STAGE
#undef PG8_LDA
#undef PG8_LDB
#undef PG8_MMA
#undef PG8_WAIT_V
#undef PG8_WAIT_L
#undef PG8_BAR
#undef PG8_SCHED
#undef PG8_UA
#undef PG8_UB
}

#define EPI_ARGS const f32x4 (&acc)[2][2][4][2], const Unit& u, int wr, int wc, int fr, int fq
#define EPI_ROWS _Pragma("unroll") for (int ai = 0; ai < 2; ++ai) _Pragma("unroll") for (int m = 0; m < 4; ++m)
#define EPI_BJ _Pragma("unroll") for (int bj = 0; bj < 2; ++bj)
DI u32x4 pk8(const f32x4 a, const f32x4 b) { u32x4 r; r.x = pk2(a[0], a[1]); r.y = pk2(a[2], a[3]); r.z = pk2(b[0], b[1]); r.w = pk2(b[2], b[3]); return r; }
DI void unpk8(const u32x4 w, f32x4& a, f32x4& b) { a[0] = bf2f(w.x & 0xffffu); a[1] = bf2f(w.x >> 16); a[2] = bf2f(w.y & 0xffffu); a[3] = bf2f(w.y >> 16); b[0] = bf2f(w.z & 0xffffu); b[1] = bf2f(w.z >> 16); b[2] = bf2f(w.w & 0xffffu); b[3] = bf2f(w.w >> 16); }
DI f32x4 sig4(const f32x4 v) { f32x4 s; s[0] = sigmoidf_(v[0]); s[1] = sigmoidf_(v[1]); s[2] = sigmoidf_(v[2]); s[3] = sigmoidf_(v[3]); return s; }

struct EpiInProj {
    bf16_t *Ug, *Q, *Kb, *Vt, *SGs, *SGa; const float* rope;
    DI void operator()(EPI_ARGS) const {
        const int pn = u.pn; const int rbase = u.pm * 256 + wr * 64 + fr;
        EPI_ROWS {
            const int r = rbase + ai * 128 + m * 16;
            const bool lat = r < MLAT;
            int b, t; if (lat) { b = r >> 11; t = r & 2047; } else { const int rr = r - MLAT; b = rr >> 8; t = rr & 255; }
            if (pn < 4) {
                EPI_BJ { const int col = pn * 256 + bj * 128 + wc * 32 + fq * 8; const int g = col >> 4, cc = col & 15;
                    bf16_t* p = Ug + (size_t)g * (UROWS_PAD * UK) + (size_t)(r >> 5) * UK + (r & 31) * 16 + cc; *(u32x4*)p = pk8(acc[ai][bj][m][0], acc[ai][bj][m][1]); }
            } else if (pn < 12) {
                const bool isq = pn < 8;
                const int pos = (wc & 1) ? (t & 63) : (t >> 6);
                const f32x4* rp = (const f32x4*)(rope + (pos * 16 + (fq & 1) * 8) * 2);
                f32x4 cs[4];
#pragma unroll
                for (int e = 0; e < 4; ++e) cs[e] = (f32x4){1.f, 0.f, 1.f, 0.f};
                if (lat) {
#pragma unroll
                    for (int e = 0; e < 4; ++e) cs[e] = rp[e];
                }
                const float sgn = (fq & 2) ? 1.f : -1.f;
                bf16_t* dst = isq ? Q + (size_t)r * 1024 : Kb + (size_t)(b * KVLEN + (lat ? t : SEQ + t)) * 1024;
                EPI_BJ {
                    f32x4 o[2];
#pragma unroll
                    for (int n = 0; n < 2; ++n)
#pragma unroll
                        for (int i = 0; i < 4; ++i) { const float v = acc[ai][bj][m][n][i]; const float pv = __shfl_xor(v, 32); const int e = n * 4 + i;
                            const float cc = cs[e >> 1][(e & 1) * 2], ss = cs[e >> 1][(e & 1) * 2 + 1]; o[n][i] = v * cc + sgn * pv * ss; }
                    if (isq) { o[0] = o[0] * QSCALE; o[1] = o[1] * QSCALE; }
                    const int col0 = (pn - (isq ? 4 : 8)) * 256 + bj * 128 + wc * 32 + fq * 8;
                    *(u32x4*)(dst + col0) = pk8(o[0], o[1]);
                }
            } else if (pn < 16) {
                const int kvpos = lat ? t : SEQ + t;
                EPI_BJ { const int colv = (pn - 12) * 256 + bj * 128 + wc * 32 + fq * 8; bf16_t* p = Vt + (size_t)(b * 1024 + colv) * KVLEN + kvpos;
                    const f32x4 v0 = acc[ai][bj][m][0], v1 = acc[ai][bj][m][1];
                    p[0] = f2bf1(v0[0]); p[KVLEN] = f2bf1(v0[1]); p[2 * KVLEN] = f2bf1(v0[2]); p[3 * KVLEN] = f2bf1(v0[3]);
                    p[4 * KVLEN] = f2bf1(v1[0]); p[5 * KVLEN] = f2bf1(v1[1]); p[6 * KVLEN] = f2bf1(v1[2]); p[7 * KVLEN] = f2bf1(v1[3]); }
            } else {
                bf16_t* dst = (pn < 24 ? SGs : SGa) + (size_t)r * 2048 + (pn - (pn < 24 ? 16 : 24)) * 256;
                EPI_BJ { const int col = bj * 128 + wc * 32 + fq * 8; *(u32x4*)(dst + col) = pk8(sig4(acc[ai][bj][m][0]), sig4(acc[ai][bj][m][1])); }
            }
        }
    }
};
struct EpiSsm1 {
    float* S;
    DI void operator()(EPI_ARGS) const {
        EPI_ROWS { const int r = u.pm * 256 + wr * 64 + fr + ai * 128 + m * 16; float* rowp = S + ((size_t)u.bz * UROWS_PAD + r) * 256;
            EPI_BJ { const int col = bj * 128 + wc * 32 + fq * 8; *(f32x4*)(rowp + col) = acc[ai][bj][m][0]; *(f32x4*)(rowp + col + 4) = acc[ai][bj][m][1]; } }
    }
};
DI float gelu_tanh(float y) { const float a = 1.5957691216057308f * (y + 0.044715f * y * y * y); return y * sigmoidf_(a); }
DI f32x4 gelu4(const f32x4 v) { f32x4 z; z[0] = gelu_tanh(v[0]); z[1] = gelu_tanh(v[1]); z[2] = gelu_tanh(v[2]); z[3] = gelu_tanh(v[3]); return z; }
struct EpiSsm3 {
    bf16_t* Z;
    DI void operator()(EPI_ARGS) const {
        EPI_ROWS { const int r = u.pm * 256 + wr * 64 + fr + ai * 128 + m * 16;
            EPI_BJ { const int coln = u.pn * 256 + bj * 128 + wc * 32 + fq * 8; const int t = coln >> 4, c = coln & 15;
                *(u32x4*)(Z + (size_t)(r * TCH + t) * 1024 + u.bz * 16 + c) = pk8(gelu4(acc[ai][bj][m][0]), gelu4(acc[ai][bj][m][1])); } }
    }
};
struct EpiGlu {
    const bf16_t* Z; const float* bglu; bf16_t* Y;
    DI void operator()(EPI_ARGS) const {
        EPI_ROWS { const int r = u.pm * 256 + wr * 64 + fr + ai * 128 + m * 16;
            EPI_BJ { const int col = u.pn * 256 + bj * 128 + wc * 32 + fq * 8; const f32x4 b0 = *(const f32x4*)(bglu + col), b1 = *(const f32x4*)(bglu + col + 4);
                f32x4 z0, z1; unpk8(*(const u32x4*)(Z + (size_t)r * 1024 + col), z0, z1);
                *(u32x4*)(Y + (size_t)r * 1024 + col) = pk8(z0 * sig4(acc[ai][bj][m][0] + b0), z1 * sig4(acc[ai][bj][m][1] + b1)); } }
    }
};
struct EpiProj1 {
    const bf16_t* SG; bf16_t* tmp;
    DI void operator()(EPI_ARGS) const {
        EPI_ROWS { const int r = u.pm * 256 + wr * 64 + fr + ai * 128 + m * 16;
            EPI_BJ { const int col = u.pn * 256 + bj * 128 + wc * 32 + fq * 8; f32x4 s0, s1; unpk8(*(const u32x4*)(SG + (size_t)r * 2048 + col), s0, s1);
                *(u32x4*)(tmp + (size_t)r * 2048 + col) = pk8(s0 * acc[ai][bj][m][0], s1 * acc[ai][bj][m][1]); } }
    }
};
struct EpiProj2 {
    const bf16_t* SG; const bf16_t* tmp; bf16_t* Mg;
    DI void operator()(EPI_ARGS) const {
        EPI_ROWS { const int r = u.pm * 256 + wr * 64 + fr + ai * 128 + m * 16;
            EPI_BJ { const int col = u.pn * 256 + bj * 128 + wc * 32 + fq * 8; f32x4 s0, s1, t0, t1; unpk8(*(const u32x4*)(SG + (size_t)r * 2048 + col), s0, s1);
                unpk8(*(const u32x4*)(tmp + (size_t)r * 2048 + col), t0, t1);
                *(u32x4*)(Mg + (size_t)r * 2048 + col) = pk8(t0 + s0 * acc[ai][bj][m][0], t1 + s1 * acc[ai][bj][m][1]); } }
    }
};
struct EpiResid {
    const float* base; const float* gate; float* out;
    DI void operator()(EPI_ARGS) const {
        EPI_ROWS { const int r = u.pm * 256 + wr * 64 + fr + ai * 128 + m * 16; const float* gp = gate + (size_t)(r >> 11) * NMOD;
            EPI_BJ { const int col = u.pn * 256 + bj * 128 + wc * 32 + fq * 8; const f32x4 g0 = *(const f32x4*)(gp + col), g1 = *(const f32x4*)(gp + col + 4);
                const float* bp = base + (size_t)r * 2048 + col; const f32x4 b0 = *(const f32x4*)(bp), b1 = *(const f32x4*)(bp + 4);
                float* op = out + (size_t)r * 2048 + col; *(f32x4*)(op) = b0 + g0 * acc[ai][bj][m][0]; *(f32x4*)(op + 4) = b1 + g1 * acc[ai][bj][m][1]; } }
    }
};
struct EpiMid {
    const float* x; const float* mod; const float* g2n; float* out; bf16_t* H2; float* rowss;
    DI void operator()(EPI_ARGS) const {
        EPI_ROWS { const int r = u.pm * 256 + wr * 64 + fr + ai * 128 + m * 16; const float* mr = mod + (size_t)(r >> 11) * NMOD; float ssq = 0.f;
            EPI_BJ { const int col = u.pn * 256 + bj * 128 + wc * 32 + fq * 8; const f32x4 g0 = *(const f32x4*)(mr + 2 * DM + col), g1 = *(const f32x4*)(mr + 2 * DM + col + 4);
                const float* bp = x + (size_t)r * 2048 + col; const f32x4 v0 = *(const f32x4*)(bp) + g0 * acc[ai][bj][m][0], v1 = *(const f32x4*)(bp + 4) + g1 * acc[ai][bj][m][1];
                float* op = out + (size_t)r * 2048 + col; *(f32x4*)(op) = v0; *(f32x4*)(op + 4) = v1;
                ssq += (v0[0] * v0[0] + v0[1] * v0[1]) + (v0[2] * v0[2] + v0[3] * v0[3]) + (v1[0] * v1[0] + v1[1] * v1[1]) + (v1[2] * v1[2] + v1[3] * v1[3]);
                const f32x4 n0 = *(const f32x4*)(g2n + col), n1 = *(const f32x4*)(g2n + col + 4), c0 = *(const f32x4*)(mr + 4 * DM + col), c1 = *(const f32x4*)(mr + 4 * DM + col + 4);
                *(u32x4*)(H2 + (size_t)r * 2048 + col) = pk8(v0 * n0 * (c0 + 1.f), v1 * n1 * (c1 + 1.f)); }
            ssq += __shfl_xor(ssq, 16); ssq += __shfl_xor(ssq, 32);
            if (fq == 0) atomicAdd(rowss + r, ssq); }
    }
};
struct EpiFfnIn {
    bf16_t* Hd; const float* rowss; const float* cgu;
    DI void operator()(EPI_ARGS) const {
        const float* cp = cgu + (size_t)((u.pm * 256) >> 11) * (2 * DFF) + u.pn * 256 + wc * 32 + fq * 8;
        const f32x4 cg0 = *(const f32x4*)(cp), cg1 = *(const f32x4*)(cp + 4), cu0 = *(const f32x4*)(cp + 128), cu1 = *(const f32x4*)(cp + 132);
        EPI_ROWS { const int r = u.pm * 256 + wr * 64 + fr + ai * 128 + m * 16;
            const float rstd = rsqrtf(rowss[r] * (1.f / DM) + 1e-6f);
            const int col = u.pn * 128 + wc * 32 + fq * 8;
            const f32x4 g0 = acc[ai][0][m][0] * rstd + cg0, g1 = acc[ai][0][m][1] * rstd + cg1, u0 = acc[ai][1][m][0] * rstd + cu0, u1 = acc[ai][1][m][1] * rstd + cu1;
            *(u32x4*)(Hd + (size_t)r * DFF + col) = pk8(g0 * sig4(g0) * u0, g1 * sig4(g1) * u1); }
    }
};
}

namespace att {
constexpr int KROWB = 272, VROWB = 144, KT_BYTES = 64 * KROWB, VT_BYTES = 128 * VROWB, BUF = KT_BYTES + VT_BYTES, XCH_OFF = 2 * BUF;
#define MFMA32(a, b, c) __builtin_amdgcn_mfma_f32_32x32x16_bf16((a), (b), (c), 0, 0, 0)
DI void attn_phase(LAS unsigned char* lds, const bf16_t* Q, const bf16_t* Kb, const bf16_t* Vt, bf16_t* O, const float* subln, const float* lamp, int G, int cblk) {
    const int tid = threadIdx.x, lane = tid & 63, w = __builtin_amdgcn_readfirstlane(tid >> 6), q32 = lane & 31, hi = lane >> 5;
    const int map = w >> 2;
    const float lam = lamp[0];
    const int krow = (q32 & ~12) | ((q32 & 4) << 1) | ((q32 & 8) >> 1);
    const int kdst = (tid >> 4) * KROWB + (tid & 15) * 16;
    const int vdst = KT_BYTES + (tid >> 3) * VROWB + (tid & 7) * 16;
    const int kfo = krow * KROWB + (map * 64 + hi * 8) * 2;
    const int vfo = KT_BYTES + q32 * VROWB + hi * 16;
    for (int L = cblk; L < NB * 8 * 16; L += G) {
        const int bh = L >> 4, qb = L & 15, b = bh >> 3, h = bh & 7;
        const int qrow = b * SEQ + qb * 128 + (w & 3) * 32 + q32;
        bf16x8 qf[4];
        { const bf16_t* qp = Q + (size_t)qrow * 1024 + h * 128 + map * 64 + hi * 8;
#pragma unroll
          for (int ds = 0; ds < 4; ++ds) qf[ds] = *(const bf16x8*)(qp + ds * 16); }
        const bf16_t* ksrc = Kb + ((size_t)(b * KVLEN) + (tid >> 4)) * 1024 + h * 128 + (tid & 15) * 8;
        const bf16_t* vsrc = Vt + ((size_t)(bh * 128) + (tid >> 3)) * KVLEN + (tid & 7) * 8;
        u32x4 kr0, kr1, vr0, vr1;
        kr0 = *(const u32x4*)(ksrc); kr1 = *(const u32x4*)(ksrc + 32 * 1024); vr0 = *(const u32x4*)(vsrc); vr1 = *(const u32x4*)(vsrc + (size_t)64 * KVLEN);
        *(LAS u32x4*)(lds + kdst) = kr0; *(LAS u32x4*)(lds + kdst + 32 * KROWB) = kr1; *(LAS u32x4*)(lds + vdst) = vr0; *(LAS u32x4*)(lds + vdst + 64 * VROWB) = vr1;
        __syncthreads();
        f32x16 o[4];
#pragma unroll
        for (int db = 0; db < 4; ++db)
#pragma unroll
            for (int r = 0; r < 16; ++r) o[db][r] = 0.f;
        float mrun = -1e30f, lsum = 0.f;
        for (int t = 0; t < KVLEN / 64; ++t) {
            const bool more = (t + 1 < KVLEN / 64);
            if (more) { const bf16_t* kp = ksrc + (size_t)(t + 1) * 64 * 1024; const bf16_t* vp = vsrc + (t + 1) * 64;
                kr0 = *(const u32x4*)(kp); kr1 = *(const u32x4*)(kp + 32 * 1024); vr0 = *(const u32x4*)(vp); vr1 = *(const u32x4*)(vp + (size_t)64 * KVLEN); }
            LAS unsigned char* bufp = lds + (t & 1) * BUF;
            f32x16 st[2];
#pragma unroll
            for (int kb = 0; kb < 2; ++kb) {
#pragma unroll
                for (int r = 0; r < 16; ++r) st[kb][r] = 0.f;
#pragma unroll
                for (int ds = 0; ds < 4; ++ds) { const bf16x8 a = *(const LAS bf16x8*)(bufp + kfo + kb * 32 * KROWB + ds * 32); st[kb] = MFMA32(a, qf[ds], st[kb]); }
            }
            float mx = st[0][0];
#pragma unroll
            for (int r = 1; r < 16; ++r) mx = fmaxf(mx, st[0][r]);
#pragma unroll
            for (int r = 0; r < 16; ++r) mx = fmaxf(mx, st[1][r]);
            mx = fmaxf(mx, __shfl_xor(mx, 32));
            if (__any(mx > mrun + 8.f)) {
                const float mn = fmaxf(mrun, mx); const float al = __builtin_amdgcn_exp2f(mrun - mn); lsum *= al; mrun = mn;
#pragma unroll
                for (int db = 0; db < 4; ++db)
#pragma unroll
                    for (int r = 0; r < 16; ++r) o[db][r] *= al;
            }
            float ps = 0.f;
#pragma unroll
            for (int kb = 0; kb < 2; ++kb)
#pragma unroll
                for (int r = 0; r < 16; ++r) { const float p = __builtin_amdgcn_exp2f(st[kb][r] - mrun); st[kb][r] = p; ps += p; }
            lsum += ps;
#pragma unroll
            for (int kb = 0; kb < 2; ++kb)
#pragma unroll
                for (int s = 0; s < 2; ++s) {
                    u32x4 pw; pw.x = pk2(st[kb][8 * s + 0], st[kb][8 * s + 1]); pw.y = pk2(st[kb][8 * s + 2], st[kb][8 * s + 3]); pw.z = pk2(st[kb][8 * s + 4], st[kb][8 * s + 5]); pw.w = pk2(st[kb][8 * s + 6], st[kb][8 * s + 7]);
                    const bf16x8 pb = __builtin_bit_cast(bf16x8, pw);
#pragma unroll
                    for (int db = 0; db < 4; ++db) { const bf16x8 a = *(const LAS bf16x8*)(bufp + vfo + db * 32 * VROWB + kb * 64 + s * 32); o[db] = MFMA32(a, pb, o[db]); }
                }
            if (more) { LAS unsigned char* nb = lds + ((t + 1) & 1) * BUF;
                *(LAS u32x4*)(nb + kdst) = kr0; *(LAS u32x4*)(nb + kdst + 32 * KROWB) = kr1; *(LAS u32x4*)(nb + vdst) = vr0; *(LAS u32x4*)(nb + vdst + 64 * VROWB) = vr1; }
            __syncthreads();
        }
        lsum += __shfl_xor(lsum, 32);
        const float inv = 1.f / lsum;
        LAS float* xp = (LAS float*)(lds + XCH_OFF) + ((w & 3) * 64) * 64 + lane;
        if (map == 1) {
#pragma unroll
            for (int db = 0; db < 4; ++db)
#pragma unroll
                for (int r = 0; r < 16; ++r) xp[(db * 16 + r) * 64] = o[db][r] * inv;
        }
        __syncthreads();
        if (map == 0) {
            float ss = 0.f;
#pragma unroll
            for (int db = 0; db < 4; ++db)
#pragma unroll
                for (int r = 0; r < 16; ++r) { const float v = o[db][r] * inv - lam * xp[(db * 16 + r) * 64]; o[db][r] = v; ss += v * v; }
            ss += __shfl_xor(ss, 32);
            const float rstd = rsqrtf(ss * (1.f / 128.f) + 1e-6f) * 0.8f;
            bf16_t* op = O + (size_t)qrow * 1024 + h * 128;
#pragma unroll
            for (int db = 0; db < 4; ++db)
#pragma unroll
                for (int r4 = 0; r4 < 4; ++r4) { const int d0 = 32 * db + 8 * r4 + 4 * hi; const f32x4 gv = *(const f32x4*)(subln + d0); f32x4 v;
                    v[0] = o[db][4 * r4 + 0] * rstd * gv[0]; v[1] = o[db][4 * r4 + 1] * rstd * gv[1]; v[2] = o[db][4 * r4 + 2] * rstd * gv[2]; v[3] = o[db][4 * r4 + 3] * rstd * gv[3];
                    *(u32x2*)(op + d0) = pk4(v); }
        }
    }
}
}

struct Args { const float* in[30]; float* out; unsigned char* ws; int ph_lo, ph_hi; };

DI void transpose_item(const float* W, int K, int Nsrc, bf16_t* WT, int dest_n0, int src_n0, int k0, LAS float* scr, int lane) {
#pragma unroll 8
    for (int i = 0; i < 32; ++i) { const int kk = 2 * i + (lane >> 5); scr[kk * 33 + (lane & 31)] = W[(size_t)(k0 + kk) * Nsrc + src_n0 + (lane & 31)]; }
    asm volatile("s_waitcnt lgkmcnt(0)" ::: "memory");
    const int c = lane & 7;
#pragma unroll
    for (int j = 0; j < 4; ++j) { const int n = (lane >> 3) + 8 * j; const LAS float* s = scr + (8 * c) * 33 + n;
        u32x4 o; o.x = pk2(s[0 * 33], s[1 * 33]); o.y = pk2(s[2 * 33], s[3 * 33]); o.z = pk2(s[4 * 33], s[5 * 33]); o.w = pk2(s[6 * 33], s[7 * 33]);
        *(u32x4*)(WT + (size_t)(dest_n0 + n) * K + k0 + 8 * c) = o; }
    asm volatile("s_waitcnt lgkmcnt(0)" ::: "memory");
}

DI void mod_item(LAS unsigned char* lds, const float* cvec, const float* cctx, const float* wada, const float* bada, float* mod, int it) {
    const int tid = threadIdx.x, lane = tid & 63, w = tid >> 6;
    LAS float* sl = (LAS float*)lds + w * (17 * 256);
    for (int idx = lane; idx < 17 * 256; idx += 64) { const int r = idx >> 8, kk = idx & 255; const float cv = (r < 16) ? cvec[r * DM + 256 * w + kk] : cctx[256 * w + kk]; sl[idx] = cv * sigmoidf_(cv); }
    asm volatile("s_waitcnt lgkmcnt(0)" ::: "memory");
    const int col = it * 64 + lane;
    float acc[17];
#pragma unroll
    for (int r = 0; r < 17; ++r) acc[r] = 0.f;
    const float* wp = wada + (size_t)(256 * w) * NMOD + col;
    for (int kk = 0; kk < 256; kk += 8) {
        float wv[8];
#pragma unroll
        for (int e = 0; e < 8; ++e) wv[e] = wp[(size_t)(kk + e) * NMOD];
#pragma unroll
        for (int r = 0; r < 17; ++r) { const f32x4 s0 = *(const LAS f32x4*)(sl + r * 256 + kk), s1 = *(const LAS f32x4*)(sl + r * 256 + kk + 4);
            acc[r] += s0[0] * wv[0] + s0[1] * wv[1] + s0[2] * wv[2] + s0[3] * wv[3] + s1[0] * wv[4] + s1[1] * wv[5] + s1[2] * wv[6] + s1[3] * wv[7]; }
    }
    __syncthreads();
    LAS float* red = (LAS float*)lds;
#pragma unroll
    for (int r = 0; r < 17; ++r) red[(w * 17 + r) * 64 + lane] = acc[r];
    __syncthreads();
    for (int idx = tid; idx < 17 * 64; idx += NTHREADS) { const int r = idx >> 6, l = idx & 63; float s = bada[it * 64 + l];
#pragma unroll
        for (int ww = 0; ww < 8; ++ww) s += red[(ww * 17 + r) * 64 + l];
        mod[(size_t)r * NMOD + it * 64 + l] = s; }
    __syncthreads();
}

DI void ssm_coef_item(LAS unsigned char* lds, const float* const* in, bf16_t* Bt3, bf16_t* Bt1, float* lamT, int g) {
    const int tid = threadIdx.x;
    LAS float* Lam = (LAS float*)lds;
    LAS float* Bb = Lam + 2 * 33 * 64 * 2;
    LAS float* Cm = Bb + 2 * 64 * 16 * 2;
    LAS float* Km = Cm + 2 * 16 * 64 * 2;
    const float* a_re = in[8]; const float* a_im = in[9]; const float* log_dt = in[10]; const float* b_re = in[11]; const float* b_im = in[12];
    const float* c_re = in[13]; const float* c_im = in[14]; const float* dsk = in[15];
    for (int idx = tid; idx < 2 * 33 * 64; idx += NTHREADS) {
        const int p = idx & 63, j = (idx >> 6) % 33, d = idx / (33 * 64);
        const double dt = exp((double)log_dt[d * 64 + g]); const double zr = (double)a_re[(d * 64 + g) * 64 + p] * dt, zi = (double)a_im[(d * 64 + g) * 64 + p] * dt;
        const double mag = exp(zr * j); double rev = zi * j * 0.15915494309189535; rev -= floor(rev + 0.5); const double ang = rev * 6.283185307179586;
        Lam[idx * 2] = (float)(mag * cos(ang)); Lam[idx * 2 + 1] = (float)(mag * sin(ang));
    }
    for (int idx = tid; idx < 2 * 64 * 16; idx += NTHREADS) {
        const int c = idx & 15, p = (idx >> 4) & 63, d = idx >> 10;
        const double dt = exp((double)log_dt[d * 64 + g]); const double lr = (double)a_re[(d * 64 + g) * 64 + p], li = (double)a_im[(d * 64 + g) * 64 + p];
        const double zr = lr * dt, zi = li * dt; const double mag = exp(zr); double rev = zi * 0.15915494309189535; rev -= floor(rev + 0.5); const double ang = rev * 6.283185307179586;
        const double er = mag * cos(ang) - 1.0, ei = mag * sin(ang);
        const double den = lr * lr + li * li; const double fr_ = (er * lr + ei * li) / den, fi_ = (ei * lr - er * li) / den;
        const double br = (double)b_re[((d * 64 + g) * 64 + p) * 16 + c], bi = (double)b_im[((d * 64 + g) * 64 + p) * 16 + c];
        Bb[idx * 2] = (float)(fr_ * br - fi_ * bi); Bb[idx * 2 + 1] = (float)(fr_ * bi + fi_ * br);
        const int c2 = (idx >> 6) & 15, p2 = idx & 63;
        Cm[idx * 2] = c_re[((d * 64 + g) * 16 + c2) * 64 + p2]; Cm[idx * 2 + 1] = c_im[((d * 64 + g) * 16 + c2) * 64 + p2];
    }
    __syncthreads();
    {
        const int cp = tid & 15, c = (tid >> 4) & 15, d = tid >> 8;
        for (int j = 0; j < 32; ++j) {
            float a = 0.f;
            for (int p = 0; p < 64; ++p) {
                const float cr = Cm[((d * 16 + c) * 64 + p) * 2], ci = Cm[((d * 16 + c) * 64 + p) * 2 + 1];
                const float lr = Lam[((d * 33 + j) * 64 + p) * 2], li = Lam[((d * 33 + j) * 64 + p) * 2 + 1];
                const float br = Bb[((d * 64 + p) * 16 + cp) * 2], bi = Bb[((d * 64 + p) * 16 + cp) * 2 + 1];
                const float vr = cr * lr - ci * li, vi = cr * li + ci * lr;
                a += vr * br - vi * bi;
            }
            Km[((d * 32 + j) * 16 + c) * 16 + cp] = a;
        }
    }
    __syncthreads();
    bf16_t* B3 = Bt3 + (size_t)g * 512 * UK;
    for (int idx = tid; idx < 512 * 96; idx += NTHREADS) {
        const int n = idx / 96, k0 = (idx % 96) * 8; const int t = n >> 4, c = n & 15;
        float v[8];
        if (k0 < 512) {
            const int s = k0 >> 4, c0 = k0 & 15;
#pragma unroll
            for (int e = 0; e < 8; ++e) { const int cp = c0 + e; float x;
                if (s < t) x = Km[((0 * 32 + (t - s)) * 16 + c) * 16 + cp];
                else if (s > t) x = Km[((1 * 32 + (s - t)) * 16 + c) * 16 + cp];
                else x = Km[(c) * 16 + cp] + Km[((32) * 16 + c) * 16 + cp] + (c == cp ? dsk[g * 16 + c] : 0.f);
                v[e] = x; }
        } else {
            const int kk = k0 - 512, sec = kk >> 6, p0 = kk & 63, d = sec >> 1, part = sec & 1; const int jj = d == 0 ? t + 1 : TCH - t;
#pragma unroll
            for (int e = 0; e < 8; ++e) { const int p = p0 + e;
                const float cr = Cm[((d * 16 + c) * 64 + p) * 2], ci = Cm[((d * 16 + c) * 64 + p) * 2 + 1];
                const float lr = Lam[((d * 33 + jj) * 64 + p) * 2], li = Lam[((d * 33 + jj) * 64 + p) * 2 + 1];
                v[e] = part == 0 ? (cr * lr - ci * li) : -(cr * li + ci * lr); }
        }
        u32x4 o; o.x = pk2(v[0], v[1]); o.y = pk2(v[2], v[3]); o.z = pk2(v[4], v[5]); o.w = pk2(v[6], v[7]);
        *(u32x4*)(B3 + (size_t)n * UK + k0) = o;
    }
    bf16_t* B1 = Bt1 + (size_t)g * 256 * 512;
    for (int idx = tid; idx < 256 * 64; idx += NTHREADS) {
        const int n = idx >> 6, k0 = (idx & 63) * 8; const int s = k0 >> 4, c0 = k0 & 15; const int d = n >> 7, part = (n >> 6) & 1, p = n & 63;
        const int ee = d == 0 ? (TCH - 1 - s) : s;
        const float lr = Lam[((d * 33 + ee) * 64 + p) * 2], li = Lam[((d * 33 + ee) * 64 + p) * 2 + 1];
        float v[8];
#pragma unroll
        for (int e = 0; e < 8; ++e) { const float br = Bb[((d * 64 + p) * 16 + c0 + e) * 2], bi = Bb[((d * 64 + p) * 16 + c0 + e) * 2 + 1]; v[e] = part == 0 ? (lr * br - li * bi) : (lr * bi + li * br); }
        u32x4 o; o.x = pk2(v[0], v[1]); o.y = pk2(v[2], v[3]); o.z = pk2(v[4], v[5]); o.w = pk2(v[6], v[7]);
        *(u32x4*)(B1 + (size_t)n * 512 + k0) = o;
    }
    for (int idx = tid; idx < 128; idx += NTHREADS) { const int d = idx >> 6, p = idx & 63; lamT[((g * 2 + d) * 64 + p) * 2] = Lam[((d * 33 + 32) * 64 + p) * 2]; lamT[((g * 2 + d) * 64 + p) * 2 + 1] = Lam[((d * 33 + 32) * 64 + p) * 2 + 1]; }
    __syncthreads();
}

DI void normmod_row(const float* xr, const float* gv, const float* sh, const float* sc, bf16_t* orow, int lane) {
    f32x4 v[8]; float ss = 0.f;
#pragma unroll
    for (int j = 0; j < 8; ++j) { v[j] = *(const f32x4*)(xr + 4 * lane + 256 * j); ss += (v[j][0] * v[j][0] + v[j][1] * v[j][1]) + (v[j][2] * v[j][2] + v[j][3] * v[j][3]); }
    const float rstd = rsqrtf(wave_sum(ss) * (1.f / DM) + 1e-6f);
#pragma unroll
    for (int j = 0; j < 8; ++j) { const int c = 4 * lane + 256 * j; const f32x4 g4 = *(const f32x4*)(gv + c), s4 = *(const f32x4*)(sh + c), c4 = *(const f32x4*)(sc + c);
        const f32x4 y = (v[j] * rstd * g4) * (c4 + 1.f) + s4; *(u32x2*)(orow + c) = pk4(y); }
}

constexpr int NPH = 14;
__global__ void __launch_bounds__(NTHREADS, 2) fwd_kernel(Args args) {
    extern __shared__ __attribute__((aligned(16))) unsigned char lds_raw[];
    LAS unsigned char* lds = (LAS unsigned char*)lds_raw;
    cg::grid_group grid = cg::this_grid();
    const int tid = threadIdx.x, lane = tid & 63, wave = __builtin_amdgcn_readfirstlane(tid >> 6);
    const int G = gridDim.x, cb = blockIdx.x;
    const int gw = cb * 8 + wave, NGW = G * 8;
    unsigned char* ws = args.ws;
    const float* x = args.in[0]; float* out = args.out;
    bf16_t* Wt_in = (bf16_t*)(ws + WS_WIN); bf16_t* Wt_glu = (bf16_t*)(ws + WS_WGLU); bf16_t* Wt_ps = (bf16_t*)(ws + WS_WPS); bf16_t* Wt_pa = (bf16_t*)(ws + WS_WPA);
    bf16_t* Wt_out = (bf16_t*)(ws + WS_WOUT); bf16_t* Wt_fi = (bf16_t*)(ws + WS_WFI); bf16_t* Wt_fo = (bf16_t*)(ws + WS_WFO);
    bf16_t* Bt3 = (bf16_t*)(ws + WS_BT3); bf16_t* Bt1 = (bf16_t*)(ws + WS_BT1);
    float* mod = (float*)(ws + WS_MOD); float* rope = (float*)(ws + WS_ROPE); float* lamS = (float*)(ws + WS_LAMS); float* lamT = (float*)(ws + WS_LAMT);
    bf16_t* Hb = (bf16_t*)(ws + WS_H); bf16_t* Oatt = (bf16_t*)(ws + WS_OATT); bf16_t* Yssm = (bf16_t*)(ws + WS_YSSM); bf16_t* H2 = (bf16_t*)(ws + WS_H2);
    bf16_t* Ug = (bf16_t*)(ws + WS_UG); float* Sst = (float*)(ws + WS_S); bf16_t* Vt = (bf16_t*)(ws + WS_VT); bf16_t* tmp = (bf16_t*)(ws + WS_TMP); bf16_t* Hid = (bf16_t*)(ws + WS_HID);
    bf16_t* Qb = (bf16_t*)(ws + WS_Q); bf16_t* Zb = (bf16_t*)(ws + WS_Z); bf16_t* Kb = (bf16_t*)(ws + WS_K); bf16_t* Mg = (bf16_t*)(ws + WS_MERGED);
    bf16_t* SGs = (bf16_t*)(ws + WS_SGS); bf16_t* SGa = (bf16_t*)(ws + WS_SGA); float* cgu = (float*)(ws + WS_CGU); float* rowss = (float*)(ws + WS_ROWSS);
    const int lo = args.ph_lo, hi_ph = args.ph_hi;
#define IN(k) (lo <= (k) && (k) < hi_ph)
#define SEAM(k) do { if (IN(k) && IN((k) + 1)) grid.sync(); } while (0)

    if (IN(0)) {
        if (cb == 0) {
            for (int idx = tid; idx < 64 * 16; idx += NTHREADS) { const int pos = idx >> 4, f = idx & 15; const float inv = powf(10000.f, -(float)f / 16.f); const float a = (float)pos * inv; rope[idx * 2] = cosf(a); rope[idx * 2 + 1] = sinf(a); }
            if (tid == 0) { float s1 = 0.f, s2 = 0.f; for (int i = 0; i < 64; ++i) { s1 += args.in[18][i] * args.in[19][i]; s2 += args.in[20][i] * args.in[21][i]; } lamS[0] = expf(s1) - expf(s2) + 0.2f; }
        }
        for (int it = cb; it < 192 + 64; it += G) {
            if (it < 192) mod_item(lds, args.in[1], args.in[3], args.in[4], args.in[5], mod, it);
            else ssm_coef_item(lds, args.in, Bt3, Bt1, lamT, it - 192);
        }
        {
            LAS float* scr = (LAS float*)(lds + wave * 16384);
            constexpr int I0 = 32 * 256, I1 = 16 * 32, I2 = 16 * 64, I3 = 16 * 64, I4 = 32 * 64, I5 = 32 * 352, I6 = 88 * 64;
            constexpr int NIT = I0 + I1 + I2 + I3 + I4 + I5 + I6;
            for (int it = gw; it < NIT; it += NGW) {
                int r = it;
                if (r < I0) { const int nblk = 256, kb = r / nblk, nb = r % nblk; transpose_item(args.in[7], DM, DIN, Wt_in, nb * 32, nb * 32, kb * 64, scr, lane); continue; } r -= I0;
                if (r < I1) { const int nblk = 32, kb = r / nblk, nb = r % nblk; transpose_item(args.in[16], 1024, 1024, Wt_glu, nb * 32, nb * 32, kb * 64, scr, lane); continue; } r -= I1;
                if (r < I2) { const int nblk = 64, kb = r / nblk, nb = r % nblk; transpose_item(args.in[23], 1024, DM, Wt_ps, nb * 32, nb * 32, kb * 64, scr, lane); continue; } r -= I2;
                if (r < I3) { const int nblk = 64, kb = r / nblk, nb = r % nblk; transpose_item(args.in[24], 1024, DM, Wt_pa, nb * 32, nb * 32, kb * 64, scr, lane); continue; } r -= I3;
                if (r < I4) { const int nblk = 64, kb = r / nblk, nb = r % nblk; transpose_item(args.in[25], DM, DM, Wt_out, nb * 32, nb * 32, kb * 64, scr, lane); continue; } r -= I4;
                if (r < I5) { const int nblk = 352, kb = r / nblk, nb = r % nblk; const int n0 = nb * 32, tile = n0 >> 8, within = n0 & 255;
                    const int src = within < 128 ? tile * 128 + within : DFF + tile * 128 + (within - 128);
                    transpose_item(args.in[27], DM, 2 * DFF, Wt_fi, n0, src, kb * 64, scr, lane); continue; } r -= I5;
                { const int nblk = 64, kb = r / nblk, nb = r % nblk; transpose_item(args.in[28], DFF, DM, Wt_fo, nb * 32, nb * 32, kb * 64, scr, lane); }
            }
        }
    }
    SEAM(0);
    if (IN(1)) {
        for (int i = cb * NTHREADS + tid; i < MLAT; i += G * NTHREADS) rowss[i] = 0.f;
        {
            LAS float* sh = (LAS float*)lds;
            for (int i = tid; i < NB * DM / 4; i += NTHREADS) { const int b = i / (DM / 4), k4 = i % (DM / 4); *(LAS f32x4*)(sh + b * DM + k4 * 4) = *(const f32x4*)(mod + (size_t)b * NMOD + 3 * DM + k4 * 4); }
            __syncthreads();
            for (int n = gw; n < 2 * DFF; n += NGW) {
                f32x4 w0[4], w1[4];
#pragma unroll
                for (int j = 0; j < 4; ++j) pg8::unpk8(*(const u32x4*)(Wt_fi + (size_t)n * DM + j * 512 + lane * 8), w0[j], w1[j]);
                float myv = 0.f;
#pragma unroll 1
                for (int b = 0; b < NB; ++b) { float a = 0.f;
#pragma unroll
                    for (int j = 0; j < 4; ++j) { const f32x4 s0 = *(const LAS f32x4*)(sh + b * DM + j * 512 + lane * 8), s1 = *(const LAS f32x4*)(sh + b * DM + j * 512 + lane * 8 + 4);
                        a += (s0[0] * w0[j][0] + s0[1] * w0[j][1]) + (s0[2] * w0[j][2] + s0[3] * w0[j][3]) + (s1[0] * w1[j][0] + s1[1] * w1[j][1]) + (s1[2] * w1[j][2] + s1[3] * w1[j][3]); }
                    a = wave_sum(a); if (lane == b) myv = a; }
                if (lane < NB) cgu[(size_t)lane * (2 * DFF) + n] = myv;
            }
            __syncthreads();
        }
        for (int row = gw; row < MTOT; row += NGW) {
            const float* xr = row < MLAT ? x + (size_t)row * DM : args.in[2] + (size_t)(row - MLAT) * DM;
            const float* mr = mod + (size_t)(row < MLAT ? (row >> 11) : 16) * NMOD;
            normmod_row(xr, args.in[6], mr, mr + DM, Hb + (size_t)row * DM, lane);
        }
    }
    SEAM(1);
    if (IN(2)) {
        pg8::Gemm g{Hb, Wt_in, DM, DM, DM, 0, 0};
        pg8::EpiInProj E{Ug, Qb, Kb, Vt, SGs, SGa, rope};
        { pg8::StaticOrder S; S.init(MLAT / 256, DIN / 256, 1, G, cb); pg8::gemm_phase(lds, g, S, E); }
        { pg8::CtxOrder S{G, cb}; pg8::gemm_phase(lds, g, S, E); }
    }
    SEAM(2);
    if (IN(3)) {
        pg8::Gemm g{Ug, Bt1, UK, 512, 512, (size_t)UROWS_PAD * UK, (size_t)256 * 512};
        pg8::EpiSsm1 E{Sst};
        pg8::StaticOrder S; S.init(UROWS_PAD / 256, 1, 64, G, cb); pg8::gemm_phase(lds, g, S, E);
    }
    SEAM(3);
    if (IN(4)) {
        for (int idx = cb * NTHREADS + tid; idx < NB * 64 * 2 * 64; idx += G * NTHREADS) {
            const int p = idx & 63, d = (idx >> 6) & 1, g = (idx >> 7) & 63, b = idx >> 13;
            const float lr = lamT[((g * 2 + d) * 64 + p) * 2], li = lamT[((g * 2 + d) * 64 + p) * 2 + 1];
            const float* Sg = Sst + (size_t)g * UROWS_PAD * 256 + d * 128 + p;
            bf16_t* Up = Ug + (size_t)g * (UROWS_PAD * UK) + 512 + d * 128 + p;
            float hr = 0.f, hi = 0.f;
#pragma unroll
            for (int kk = 0; kk < 8; ++kk) { const int k = d ? 7 - kk : kk; const float* sp = Sg + (size_t)(1024 + b * 8 + k) * 256; const float sr = sp[0], si = sp[64];
                const float nr = lr * hr - li * hi + sr, ni = lr * hi + li * hr + si; hr = nr; hi = ni; }
#pragma unroll 8
            for (int kk = 0; kk < 64; ++kk) { const int k = d ? 63 - kk : kk; const int row = b * 64 + k; bf16_t* up = Up + (size_t)row * UK; up[0] = f2bf1(hr); up[64] = f2bf1(hi);
                const float* sp = Sg + (size_t)row * 256; const float sr = sp[0], si = sp[64];
                const float nr = lr * hr - li * hi + sr, ni = lr * hi + li * hr + si; hr = nr; hi = ni; }
        }
        att::attn_phase(lds, Qb, Kb, Vt, Oatt, args.in[22], lamS, G, cb);
    }
    SEAM(4);
    if (IN(5)) {
        pg8::Gemm g{Ug, Bt3, UK, UK, UK, (size_t)UROWS_PAD * UK, (size_t)512 * UK};
        pg8::EpiSsm3 E{Zb};
        pg8::StaticOrder S; S.init(4, 2, 64, G, cb); pg8::gemm_phase(lds, g, S, E);
    }
    SEAM(5);
    if (IN(6)) {
        pg8::Gemm g{Zb, Wt_glu, 1024, 1024, 1024, 0, 0};
        pg8::EpiGlu E{Zb, args.in[17], Yssm};
        pg8::StaticOrder S; S.init(MLAT / 256, 4, 1, G, cb); pg8::gemm_phase(lds, g, S, E);
    }
    SEAM(6);
    if (IN(7)) {
        pg8::Gemm g{Yssm, Wt_ps, 1024, 1024, 1024, 0, 0};
        pg8::EpiProj1 E{SGs, tmp};
        pg8::StaticOrder S; S.init(MLAT / 256, 8, 1, G, cb); pg8::gemm_phase(lds, g, S, E);
    }
    SEAM(7);
    if (IN(8)) {
        pg8::Gemm g{Oatt, Wt_pa, 1024, 1024, 1024, 0, 0};
        pg8::EpiProj2 E{SGa, tmp, Mg};
        pg8::StaticOrder S; S.init(MLAT / 256, 8, 1, G, cb); pg8::gemm_phase(lds, g, S, E);
    }
    SEAM(8);
    if (IN(9)) {
        pg8::Gemm g{Mg, Wt_out, DM, DM, DM, 0, 0};
        pg8::EpiMid E{x, mod, args.in[26], out, H2, rowss};
        pg8::StaticOrder S; S.init(MLAT / 256, 8, 1, G, cb); pg8::gemm_phase(lds, g, S, E);
    }
    SEAM(9);
    if (IN(11)) {
        pg8::Gemm g{H2, Wt_fi, DM, DM, DM, 0, 0};
        pg8::EpiFfnIn E{Hid, rowss, cgu};
        pg8::StaticOrder S; S.init(MLAT / 256, 44, 1, G, cb); pg8::gemm_phase(lds, g, S, E);
    }
    SEAM(11);
    if (IN(12)) {
        pg8::Gemm g{Hid, Wt_fo, DFF, DFF, DFF, 0, 0};
        pg8::EpiResid E{out, mod + 5 * DM, out};
        pg8::StaticOrder S; S.init(MLAT / 256, 8, 1, G, cb); pg8::gemm_phase(lds, g, S, E);
    }
    SEAM(12);
    if (IN(13)) {
        const float* gf = args.in[29];
        for (int row = gw; row < MLAT; row += NGW) {
            float* xr = out + (size_t)row * DM; f32x4 v[8]; float ss = 0.f;
#pragma unroll
            for (int j = 0; j < 8; ++j) { v[j] = *(const f32x4*)(xr + 4 * lane + 256 * j); ss += (v[j][0] * v[j][0] + v[j][1] * v[j][1]) + (v[j][2] * v[j][2] + v[j][3] * v[j][3]); }
            const float rstd = rsqrtf(wave_sum(ss) * (1.f / DM) + 1e-6f);
#pragma unroll
            for (int j = 0; j < 8; ++j) { const int c = 4 * lane + 256 * j; const f32x4 g4 = *(const f32x4*)(gf + c); *(f32x4*)(xr + c) = v[j] * rstd * g4; }
        }
    }
#undef IN
#undef SEAM
}

#ifndef SEGMENTS
#define SEGMENTS 0, 14
#endif
extern "C" void kernel_launch(void* const* d_in, const int* in_sizes, int n_in, void* d_out, int out_size, void* d_ws, size_t ws_size, hipStream_t stream) {
    static int grid = 0;
    if (grid == 0) {
        if (n_in != 30 || out_size != MLAT * DM || ws_size < WS_END) { fprintf(stderr, "kernel_launch: unexpected shapes (n_in %d out %d ws %zu)\n", n_in, out_size, ws_size); grid = -1; return; }
        int dev = 0, cus = 0, per_cu = 0;
        (void)hipGetDevice(&dev);
        (void)hipDeviceGetAttribute(&cus, hipDeviceAttributeMultiprocessorCount, dev);
        if (hipFuncSetAttribute((const void*)fwd_kernel, hipFuncAttributeMaxDynamicSharedMemorySize, LDS_BYTES) != hipSuccess) { fprintf(stderr, "kernel_launch: hipFuncSetAttribute failed\n"); grid = -1; return; }
        if (hipOccupancyMaxActiveBlocksPerMultiprocessor(&per_cu, (const void*)fwd_kernel, NTHREADS, LDS_BYTES) != hipSuccess || per_cu < 1) { fprintf(stderr, "kernel_launch: occupancy query says %d\n", per_cu); per_cu = 1; }
        (void)hipGetLastError();
        grid = cus * per_cu;
        fprintf(stderr, "kernel_launch: grid %d (cus %d x %d)\n", grid, cus, per_cu);
    }
    if (grid < 0) return;
    Args a{};
    for (int i = 0; i < 30; ++i) a.in[i] = (const float*)d_in[i];
    a.out = (float*)d_out; a.ws = (unsigned char*)d_ws;
    const int segs[] = {SEGMENTS};
    for (int si = 0; si + 1 < (int)(sizeof(segs) / sizeof(int)); si += 2) {
        a.ph_lo = segs[si]; a.ph_hi = segs[si + 1];
        void* kargs[] = {&a};
        hipError_t e = hipLaunchCooperativeKernel((const void*)fwd_kernel, dim3(grid), dim3(NTHREADS), kargs, LDS_BYTES, stream);
        if (e != hipSuccess) fprintf(stderr, "kernel_launch: cooperative launch failed: %s (grid %d)\n", hipGetErrorString(e), grid);
    }
}
```

```cpp
#include <hip/hip_runtime.h>
#include <hip/hip_cooperative_groups.h>
#include <cstdio>
#include <cstdint>
namespace cg = cooperative_groups;

#define LAS __attribute__((address_space(3)))
#define DI __device__ __forceinline__
typedef unsigned short bf16_t;
typedef short bf16x8 __attribute__((ext_vector_type(8)));
typedef float f32x4 __attribute__((ext_vector_type(4)));
typedef float f32x16 __attribute__((ext_vector_type(16)));
typedef unsigned u32x4 __attribute__((ext_vector_type(4)));
typedef unsigned u32x2 __attribute__((ext_vector_type(2)));
typedef float f32x2_t __attribute__((ext_vector_type(2)));
typedef __bf16 bf16x2_t __attribute__((ext_vector_type(2)));

constexpr int DM = 2048, NB = 16, SEQ = 2048, LCTX = 256, MLAT = NB * SEQ, MCTX = NB * LCTX, MTOT = MLAT + MCTX;
constexpr int KVLEN = SEQ + LCTX;
constexpr int DFF = 5632, DIN = 8192, NMOD = 6 * DM;
constexpr int TCH = 32;
constexpr int UROWS_PAD = 1280, UK = 768;
constexpr float QSCALE = 0.125f * 1.4426950408889634f;
constexpr int NTHREADS = 512;
constexpr int LDS_BYTES = 147456;

constexpr size_t MiB = 1u << 20;
constexpr size_t WS_WIN = 0, WS_WGLU = 32 * MiB, WS_WPS = 34 * MiB, WS_WPA = 38 * MiB, WS_WOUT = 42 * MiB, WS_WFI = 50 * MiB, WS_WFO = 94 * MiB;
constexpr size_t WS_BT3 = 116 * MiB, WS_BT1 = 164 * MiB, WS_MOD = 180 * MiB, WS_ROPE = 181 * MiB, WS_LAMS = 181 * MiB + 16384, WS_LAMT = 181 * MiB + 32768, WS_CTR = 181 * MiB + 131072;
constexpr size_t WS_H = 182 * MiB, WS_OATT = 182 * MiB, WS_YSSM = 246 * MiB, WS_H2 = 182 * MiB;
constexpr size_t WS_UG = 326 * MiB, WS_S = 446 * MiB, WS_VT = 526 * MiB, WS_TMP = 326 * MiB, WS_HID = 326 * MiB;
constexpr size_t WS_Q = 598 * MiB, WS_Z = 598 * MiB, WS_K = 662 * MiB, WS_MERGED = 598 * MiB;
constexpr size_t WS_SGS = 734 * MiB, WS_SGA = 862 * MiB, WS_END = 990 * MiB;

DI unsigned pk2(float lo, float hi) { f32x2_t v = {lo, hi}; bf16x2_t b = __builtin_convertvector(v, bf16x2_t); return __builtin_bit_cast(unsigned, b); }
DI u32x2 pk4(f32x4 v) { u32x2 r; r.x = pk2(v[0], v[1]); r.y = pk2(v[2], v[3]); return r; }
DI float bf2f(unsigned h) { return __uint_as_float(h << 16); }
DI f32x4 unpk4(u32x2 w) { f32x4 r; r[0] = bf2f(w.x & 0xffffu); r[1] = bf2f(w.x >> 16); r[2] = bf2f(w.y & 0xffffu); r[3] = bf2f(w.y >> 16); return r; }
DI bf16_t f2bf1(float f) { return (bf16_t)(pk2(f, 0.f) & 0xffffu); }
DI float sigmoidf_(float x) { return __builtin_amdgcn_rcpf(1.f + __expf(-x)); }
DI float wave_sum(float v) {
#pragma unroll
    for (int o = 1; o < 64; o <<= 1) v += __shfl_xor(v, o);
    return v;
}

namespace pg8 {
constexpr int BM = 256, BK = 64, HALF = 128, HTB = HALF * BK * 2, STAGE_BYTES = 8 * HTB, NXCD = 8, WGM = 8;
__host__ __device__ __forceinline__ int lds_byte(int r, int c) { const int st = (r >> 4) * 2 + (c >> 5), rr = r & 15, cc = c & 31, ob = rr * 64 + cc * 2; return st * 1024 + (ob ^ (((ob >> 9) & 1) << 5)); }
__host__ __device__ __forceinline__ int perm32(int rho) { const int n = rho >> 4, i = rho & 15; return 8 * (i >> 2) + 4 * n + (i & 3); }
__host__ __device__ __forceinline__ void stage_rc(int b, int& R, int& C) { const int st = b / 1024, sb = b % 1024, swz = sb ^ (((sb >> 9) & 1) << 5); R = (st >> 1) * 16 + swz / 64; C = (st & 1) * 32 + (swz % 64) / 2; }

struct Unit { int pm, pn, bz; };
struct Gemm { const bf16_t* A; const bf16_t* Bt; int lda, ldb, K; size_t sA, sB; };

struct StaticOrder {
    int nM, nN, nB, nwg, G, c;
    DI void init(int nM_, int nN_, int nB_, int G_, int c_) { nM = nM_; nN = nN_; nB = nB_; nwg = nM_ * nN_; G = G_; c = c_; }
    DI bool next(int i, Unit& u) const {
        const int tot = nwg * nB; const long L = (long)i * G + c; if (L >= tot) return false;
        int wg = (int)L; { const int q = tot / NXCD, r = tot % NXCD, xcd = wg % NXCD, off = wg / NXCD; wg = (xcd < r ? xcd * (q + 1) : r * (q + 1) + (xcd - r) * q) + off; }
        u.bz = wg / nwg; const int wgid = wg % nwg;
        const int nig = WGM * nN, gid = wgid / nig, fm = gid * WGM, gsz = (nM - fm) < WGM ? (nM - fm) : WGM;
        u.pm = fm + ((wgid % nig) % gsz); u.pn = (wgid % nig) / gsz; return true;
    }
};
struct CtxOrder {
    int G, c;
    DI bool next(int i, Unit& u) const {
        const int L = i * G + c; if (L >= 16 * 12) return false;
        u.bz = 0; u.pm = 128 + L / 12; const int j = L % 12; u.pn = j < 4 ? j : j + 4; return true;
    }
};

template <class Epi, class Sched>
DI void gemm_phase(LAS unsigned char* lds, const Gemm g, const Sched& S, const Epi& E) {
    const int tid = threadIdx.x, wid = __builtin_amdgcn_readfirstlane(tid >> 6), lane = tid & 63, wr = wid >> 2, wc = wid & 3, fr = lane & 15, fq = lane >> 4;
    const int K = g.K, nt = K / BK;
    unsigned voffA[2], voffB[2];
#pragma unroll
    for (int i = 0; i < 2; ++i) { int R, C; stage_rc(tid * 16 + i * 8192, R, C); const int Rb = (R & ~31) + perm32(R & 31); voffA[i] = (unsigned)(R * g.lda + C) * 2u; voffB[i] = (unsigned)(Rb * g.ldb + C) * 2u; }
    const size_t kstep = (size_t)(BK * 2);
    const size_t hsA = (size_t)HALF * g.lda * 2, hsB = (size_t)HALF * g.ldb * 2;
    const unsigned ldsw = (unsigned)wid * 1024u;
    const int aoff = lds_byte(wr * 64 + fr, fq * 8), boff = lds_byte(wc * 32 + fr, fq * 8);
#define PG8_SA(b, h) (((b) * 2 + (h)) * HTB)
#define PG8_SB(b, h) ((4 + (b) * 2 + (h)) * HTB)
#define PG8_STAGE(bufoff, gbase, voff) do { _Pragma("unroll") for (int _i = 0; _i < 2; ++_i) \
        __builtin_amdgcn_global_load_lds((const unsigned*)((const char*)(gbase) + (voff)[_i]), (LAS unsigned*)(lds + (bufoff) + ldsw + _i * 8192), 16, 0, 0); } while (0)
#define PG8_LDA(dst, b, h) do { _Pragma("unroll") for (int m = 0; m < 4; ++m) _Pragma("unroll") for (int k = 0; k < 2; ++k) dst[m][k] = *(const LAS bf16x8*)(lds + PG8_SA(b, h) + aoff + m * 2048 + k * 1024); } while (0)
#define PG8_LDB(dst, b, h) do { _Pragma("unroll") for (int n = 0; n < 2; ++n) _Pragma("unroll") for (int k = 0; k < 2; ++k) dst[n][k] = *(const LAS bf16x8*)(lds + PG8_SB(b, h) + boff + n * 2048 + k * 1024); } while (0)
#define PG8_MMA(ai, bj, At, Bt) do { __builtin_amdgcn_s_setprio(1); _Pragma("unroll") for (int m = 0; m < 4; ++m) _Pragma("unroll") for (int n = 0; n < 2; ++n) _Pragma("unroll") for (int k = 0; k < 2; ++k) \
        acc[ai][bj][m][n] = __builtin_amdgcn_mfma_f32_16x16x32_bf16(Bt[n][k], At[m][k], acc[ai][bj][m][n], 0, 0, 0); __builtin_amdgcn_s_setprio(0); } while (0)
#define PG8_WAIT_V(n) asm volatile("s_waitcnt vmcnt(" #n ")" ::: "memory")
#define PG8_WAIT_L(n) asm volatile("s_waitcnt lgkmcnt(" #n ")" ::: "memory")
#define PG8_BAR __builtin_amdgcn_s_barrier()
#define PG8_SCHED __builtin_amdgcn_sched_barrier(0)
#define PG8_UA(u) ((const char*)g.A + ((size_t)(u).bz * g.sA + (size_t)(u).pm * BM * g.lda) * 2)
#define PG8_UB(u) ((const char*)g.Bt + ((size_t)(u).bz * g.sB + (size_t)(u).pn * BM * g.ldb) * 2)
    Unit cur, nxt; int ui = 0;
    if (!S.next(0, cur)) return;
    f32x4 acc[2][2][4][2];
#pragma unroll
    for (int a = 0; a < 2; ++a)
#pragma unroll
        for (int b = 0; b < 2; ++b)
#pragma unroll
            for (int m = 0; m < 4; ++m)
#pragma unroll
                for (int n = 0; n < 2; ++n) acc[a][b][m][n] = (f32x4){0.f, 0.f, 0.f, 0.f};
    bf16x8 At[4][2], B0[2][2], B1[2][2];
    const char* cA = PG8_UA(cur); const char* cB = PG8_UB(cur);
    PG8_STAGE(PG8_SB(0, 0), cB, voffB); PG8_STAGE(PG8_SB(0, 1), cB + hsB, voffB); PG8_STAGE(PG8_SA(0, 0), cA, voffA); PG8_STAGE(PG8_SA(0, 1), cA + hsA, voffA);
    if (wr == 1) PG8_BAR;
    PG8_WAIT_V(2); PG8_BAR;
    PG8_STAGE(PG8_SB(1, 0), cB + kstep, voffB); PG8_STAGE(PG8_SA(1, 0), cA + kstep, voffA); PG8_STAGE(PG8_SB(1, 1), cB + hsB + kstep, voffB);
    PG8_WAIT_V(6); PG8_BAR;
    for (;;) {
        const bool has_next = S.next(ui + 1, nxt);
        const char* nA = has_next ? PG8_UA(nxt) : cA; const char* nB = has_next ? PG8_UB(nxt) : cB;
        for (int t = 0; t < nt; t += 2) {
            const bool last = (t == nt - 2);
            const char* a1 = cA + (size_t)(t + 1) * kstep;
            const char* a2 = last ? nA : cA + (size_t)(t + 2) * kstep; const char* b2 = last ? nB : cB + (size_t)(t + 2) * kstep;
            const char* a3 = a2 + kstep; const char* b3 = b2 + kstep;
            PG8_LDB(B0, 0, 0); PG8_LDB(B1, 0, 1); PG8_SCHED; PG8_LDA(At, 0, 0); PG8_STAGE(PG8_SA(1, 1), a1 + hsA, voffA);
            PG8_WAIT_V(8); PG8_WAIT_L(0); PG8_BAR; PG8_MMA(0, 0, At, B0); PG8_MMA(0, 1, At, B1); PG8_BAR; PG8_SCHED;
            PG8_LDA(At, 0, 1); PG8_STAGE(PG8_SB(0, 0), b2, voffB); PG8_STAGE(PG8_SB(0, 1), b2 + hsB, voffB); PG8_STAGE(PG8_SA(0, 0), a2, voffA);
            PG8_WAIT_V(8); PG8_WAIT_L(0); PG8_BAR; PG8_MMA(1, 0, At, B0); PG8_MMA(1, 1, At, B1); PG8_BAR; PG8_SCHED;
            PG8_LDB(B0, 1, 0); PG8_LDB(B1, 1, 1); PG8_SCHED; PG8_LDA(At, 1, 0); PG8_STAGE(PG8_SA(0, 1), a2 + hsA, voffA);
            PG8_WAIT_V(8); PG8_WAIT_L(0); PG8_BAR; PG8_MMA(0, 0, At, B0); PG8_MMA(0, 1, At, B1); PG8_BAR; PG8_SCHED;
            PG8_LDA(At, 1, 1); PG8_STAGE(PG8_SB(1, 0), b3, voffB); PG8_STAGE(PG8_SB(1, 1), b3 + hsB, voffB); PG8_STAGE(PG8_SA(1, 0), a3, voffA);
            PG8_WAIT_V(8); PG8_WAIT_L(0); PG8_BAR; PG8_MMA(1, 0, At, B0); PG8_MMA(1, 1, At, B1); PG8_BAR; PG8_SCHED;
        }
        if (wr == 0) PG8_BAR;
        E(acc, cur, wr, wc, fr, fq);
        if (!has_next) break;
#pragma unroll
        for (int a = 0; a < 2; ++a)
#pragma unroll
            for (int b = 0; b < 2; ++b)
#pragma unroll
                for (int m = 0; m < 4; ++m)
#pragma unroll
                    for (int n = 0; n < 2; ++n) acc[a][b][m][n] = (f32x4){0.f, 0.f, 0.f, 0.f};
        cur = nxt; cA = nA; cB = nB; ++ui;
        if (wr == 1) PG8_BAR;
    }
    PG8_WAIT_V(0);
    PG8_BAR;
#undef PG8_SA
#undef PG8_SB
#undef PG8_STAGE
#undef PG8_LDA
#undef PG8_LDB
#undef PG8_MMA
#undef PG8_WAIT_V
#undef PG8_WAIT_L
#undef PG8_BAR
#undef PG8_SCHED
#undef PG8_UA
#undef PG8_UB
}

#define EPI_ARGS const f32x4 (&acc)[2][2][4][2], const Unit& u, int wr, int wc, int fr, int fq
#define EPI_ROWS _Pragma("unroll") for (int ai = 0; ai < 2; ++ai) _Pragma("unroll") for (int m = 0; m < 4; ++m)
#define EPI_BJ _Pragma("unroll") for (int bj = 0; bj < 2; ++bj)
DI u32x4 pk8(const f32x4 a, const f32x4 b) { u32x4 r; r.x = pk2(a[0], a[1]); r.y = pk2(a[2], a[3]); r.z = pk2(b[0], b[1]); r.w = pk2(b[2], b[3]); return r; }
DI void unpk8(const u32x4 w, f32x4& a, f32x4& b) { a[0] = bf2f(w.x & 0xffffu); a[1] = bf2f(w.x >> 16); a[2] = bf2f(w.y & 0xffffu); a[3] = bf2f(w.y >> 16); b[0] = bf2f(w.z & 0xffffu); b[1] = bf2f(w.z >> 16); b[2] = bf2f(w.w & 0xffffu); b[3] = bf2f(w.w >> 16); }
DI f32x4 sig4(const f32x4 v) { f32x4 s; s[0] = sigmoidf_(v[0]); s[1] = sigmoidf_(v[1]); s[2] = sigmoidf_(v[2]); s[3] = sigmoidf_(v[3]); return s; }

struct EpiInProj {
    bf16_t *Ug, *Q, *Kb, *Vt, *SGs, *SGa; const float* rope;
    DI void operator()(EPI_ARGS) const {
        const int pn = u.pn; const int rbase = u.pm * 256 + wr * 64 + fr;
        EPI_ROWS {
            const int r = rbase + ai * 128 + m * 16;
            const bool lat = r < MLAT;
            int b, t; if (lat) { b = r >> 11; t = r & 2047; } else { const int rr = r - MLAT; b = rr >> 8; t = rr & 255; }
            if (pn < 4) {
                EPI_BJ { const int col = pn * 256 + bj * 128 + wc * 32 + fq * 8; const int g = col >> 4, cc = col & 15;
                    bf16_t* p = Ug + (size_t)g * (UROWS_PAD * UK) + (size_t)(r >> 5) * UK + (r & 31) * 16 + cc; *(u32x4*)p = pk8(acc[ai][bj][m][0], acc[ai][bj][m][1]); }
            } else if (pn < 12) {
                const bool isq = pn < 8;
                const int pos = (wc & 1) ? (t & 63) : (t >> 6);
                const f32x4* rp = (const f32x4*)(rope + (pos * 16 + (fq & 1) * 8) * 2);
                f32x4 cs[4];
#pragma unroll
                for (int e = 0; e < 4; ++e) cs[e] = (f32x4){1.f, 0.f, 1.f, 0.f};
                if (lat) {
#pragma unroll
                    for (int e = 0; e < 4; ++e) cs[e] = rp[e];
                }
                const float sgn = (fq & 2) ? 1.f : -1.f;
                bf16_t* dst = isq ? Q + (size_t)r * 1024 : Kb + (size_t)(b * KVLEN + (lat ? t : SEQ + t)) * 1024;
                EPI_BJ {
                    f32x4 o[2];
#pragma unroll
                    for (int n = 0; n < 2; ++n)
#pragma unroll
                        for (int i = 0; i < 4; ++i) { const float v = acc[ai][bj][m][n][i]; const float pv = __shfl_xor(v, 32); const int e = n * 4 + i;
                            const float cc = cs[e >> 1][(e & 1) * 2], ss = cs[e >> 1][(e & 1) * 2 + 1]; o[n][i] = v * cc + sgn * pv * ss; }
                    if (isq) { o[0] = o[0] * QSCALE; o[1] = o[1] * QSCALE; }
                    const int col0 = (pn - (isq ? 4 : 8)) * 256 + bj * 128 + wc * 32 + fq * 8;
                    *(u32x4*)(dst + col0) = pk8(o[0], o[1]);
                }
            } else if (pn < 16) {
                const int kvpos = lat ? t : SEQ + t;
                EPI_BJ { const int colv = (pn - 12) * 256 + bj * 128 + wc * 32 + fq * 8; bf16_t* p = Vt + (size_t)(b * 1024 + colv) * KVLEN + kvpos;
                    const f32x4 v0 = acc[ai][bj][m][0], v1 = acc[ai][bj][m][1];
                    p[0] = f2bf1(v0[0]); p[KVLEN] = f2bf1(v0[1]); p[2 * KVLEN] = f2bf1(v0[2]); p[3 * KVLEN] = f2bf1(v0[3]);
                    p[4 * KVLEN] = f2bf1(v1[0]); p[5 * KVLEN] = f2bf1(v1[1]); p[6 * KVLEN] = f2bf1(v1[2]); p[7 * KVLEN] = f2bf1(v1[3]); }
            } else {
                bf16_t* dst = (pn < 24 ? SGs : SGa) + (size_t)r * 2048 + (pn - (pn < 24 ? 16 : 24)) * 256;
                EPI_BJ { const int col = bj * 128 + wc * 32 + fq * 8; *(u32x4*)(dst + col) = pk8(sig4(acc[ai][bj][m][0]), sig4(acc[ai][bj][m][1])); }
            }
        }
    }
};
struct EpiSsm1 {
    float* S;
    DI void operator()(EPI_ARGS) const {
        EPI_ROWS { const int r = u.pm * 256 + wr * 64 + fr + ai * 128 + m * 16; float* rowp = S + ((size_t)u.bz * UROWS_PAD + r) * 256;
            EPI_BJ { const int col = bj * 128 + wc * 32 + fq * 8; *(f32x4*)(rowp + col) = acc[ai][bj][m][0]; *(f32x4*)(rowp + col + 4) = acc[ai][bj][m][1]; } }
    }
};
DI float gelu_tanh(float y) { const float a = 1.5957691216057308f * (y + 0.044715f * y * y * y); return y * sigmoidf_(a); }
DI f32x4 gelu4(const f32x4 v) { f32x4 z; z[0] = gelu_tanh(v[0]); z[1] = gelu_tanh(v[1]); z[2] = gelu_tanh(v[2]); z[3] = gelu_tanh(v[3]); return z; }
struct EpiSsm3 {
    bf16_t* Z;
    DI void operator()(EPI_ARGS) const {
        EPI_ROWS { const int r = u.pm * 256 + wr * 64 + fr + ai * 128 + m * 16;
            EPI_BJ { const int coln = u.pn * 256 + bj * 128 + wc * 32 + fq * 8; const int t = coln >> 4, c = coln & 15;
                *(u32x4*)(Z + (size_t)(r * TCH + t) * 1024 + u.bz * 16 + c) = pk8(gelu4(acc[ai][bj][m][0]), gelu4(acc[ai][bj][m][1])); } }
    }
};
struct EpiGlu {
    const bf16_t* Z; const float* bglu; bf16_t* Y;
    DI void operator()(EPI_ARGS) const {
        EPI_ROWS { const int r = u.pm * 256 + wr * 64 + fr + ai * 128 + m * 16;
            EPI_BJ { const int col = u.pn * 256 + bj * 128 + wc * 32 + fq * 8; const f32x4 b0 = *(const f32x4*)(bglu + col), b1 = *(const f32x4*)(bglu + col + 4);
                f32x4 z0, z1; unpk8(*(const u32x4*)(Z + (size_t)r * 1024 + col), z0, z1);
                *(u32x4*)(Y + (size_t)r * 1024 + col) = pk8(z0 * sig4(acc[ai][bj][m][0] + b0), z1 * sig4(acc[ai][bj][m][1] + b1)); } }
    }
};
struct EpiProj1 {
    const bf16_t* SG; bf16_t* tmp;
    DI void operator()(EPI_ARGS) const {
        EPI_ROWS { const int r = u.pm * 256 + wr * 64 + fr + ai * 128 + m * 16;
            EPI_BJ { const int col = u.pn * 256 + bj * 128 + wc * 32 + fq * 8; f32x4 s0, s1; unpk8(*(const u32x4*)(SG + (size_t)r * 2048 + col), s0, s1);
                *(u32x4*)(tmp + (size_t)r * 2048 + col) = pk8(s0 * acc[ai][bj][m][0], s1 * acc[ai][bj][m][1]); } }
    }
};
struct EpiProj2 {
    const bf16_t* SG; const bf16_t* tmp; bf16_t* Mg;
    DI void operator()(EPI_ARGS) const {
        EPI_ROWS { const int r = u.pm * 256 + wr * 64 + fr + ai * 128 + m * 16;
            EPI_BJ { const int col = u.pn * 256 + bj * 128 + wc * 32 + fq * 8; f32x4 s0, s1, t0, t1; unpk8(*(const u32x4*)(SG + (size_t)r * 2048 + col), s0, s1);
                unpk8(*(const u32x4*)(tmp + (size_t)r * 2048 + col), t0, t1);
                *(u32x4*)(Mg + (size_t)r * 2048 + col) = pk8(t0 + s0 * acc[ai][bj][m][0], t1 + s1 * acc[ai][bj][m][1]); } }
    }
};
struct EpiResid {
    const float* base; const float* gate; float* out;
    DI void operator()(EPI_ARGS) const {
        EPI_ROWS { const int r = u.pm * 256 + wr * 64 + fr + ai * 128 + m * 16; const float* gp = gate + (size_t)(r >> 11) * NMOD;
            EPI_BJ { const int col = u.pn * 256 + bj * 128 + wc * 32 + fq * 8; const f32x4 g0 = *(const f32x4*)(gp + col), g1 = *(const f32x4*)(gp + col + 4);
                const float* bp = base + (size_t)r * 2048 + col; const f32x4 b0 = *(const f32x4*)(bp), b1 = *(const f32x4*)(bp + 4);
                float* op = out + (size_t)r * 2048 + col; *(f32x4*)(op) = b0 + g0 * acc[ai][bj][m][0]; *(f32x4*)(op + 4) = b1 + g1 * acc[ai][bj][m][1]; } }
    }
};
struct EpiFfnIn {
    bf16_t* Hd;
    DI void operator()(EPI_ARGS) const {
        EPI_ROWS { const int r = u.pm * 256 + wr * 64 + fr + ai * 128 + m * 16;
            const int col = u.pn * 128 + wc * 32 + fq * 8;
            const f32x4 g0 = acc[ai][0][m][0], g1 = acc[ai][0][m][1];
            *(u32x4*)(Hd + (size_t)r * DFF + col) = pk8(g0 * sig4(g0) * acc[ai][1][m][0], g1 * sig4(g1) * acc[ai][1][m][1]); }
    }
};
}

namespace att {
constexpr int KROWB = 272, VROWB = 144, KT_BYTES = 64 * KROWB, VT_BYTES = 128 * VROWB, BUF = KT_BYTES + VT_BYTES, XCH_OFF = 2 * BUF;
#define MFMA32(a, b, c) __builtin_amdgcn_mfma_f32_32x32x16_bf16((a), (b), (c), 0, 0, 0)
DI void attn_phase(LAS unsigned char* lds, const bf16_t* Q, const bf16_t* Kb, const bf16_t* Vt, bf16_t* O, const float* subln, const float* lamp, int G, int cblk) {
    const int tid = threadIdx.x, lane = tid & 63, w = __builtin_amdgcn_readfirstlane(tid >> 6), q32 = lane & 31, hi = lane >> 5;
    const int map = w >> 2;
    const float lam = lamp[0];
    const int krow = (q32 & ~12) | ((q32 & 4) << 1) | ((q32 & 8) >> 1);
    const int kdst = (tid >> 4) * KROWB + (tid & 15) * 16;
    const int vdst = KT_BYTES + (tid >> 3) * VROWB + (tid & 7) * 16;
    const int kfo = krow * KROWB + (map * 64 + hi * 8) * 2;
    const int vfo = KT_BYTES + q32 * VROWB + hi * 16;
    for (int L = cblk; L < NB * 8 * 16; L += G) {
        const int bh = L >> 4, qb = L & 15, b = bh >> 3, h = bh & 7;
        const int qrow = b * SEQ + qb * 128 + (w & 3) * 32 + q32;
        bf16x8 qf[4];
        { const bf16_t* qp = Q + (size_t)qrow * 1024 + h * 128 + map * 64 + hi * 8;
#pragma unroll
          for (int ds = 0; ds < 4; ++ds) qf[ds] = *(const bf16x8*)(qp + ds * 16); }
        const bf16_t* ksrc = Kb + ((size_t)(b * KVLEN) + (tid >> 4)) * 1024 + h * 128 + (tid & 15) * 8;
        const bf16_t* vsrc = Vt + ((size_t)(bh * 128) + (tid >> 3)) * KVLEN + (tid & 7) * 8;
        u32x4 kr0, kr1, vr0, vr1;
        kr0 = *(const u32x4*)(ksrc); kr1 = *(const u32x4*)(ksrc + 32 * 1024); vr0 = *(const u32x4*)(vsrc); vr1 = *(const u32x4*)(vsrc + (size_t)64 * KVLEN);
        *(LAS u32x4*)(lds + kdst) = kr0; *(LAS u32x4*)(lds + kdst + 32 * KROWB) = kr1; *(LAS u32x4*)(lds + vdst) = vr0; *(LAS u32x4*)(lds + vdst + 64 * VROWB) = vr1;
        __syncthreads();
        f32x16 o[4];
#pragma unroll
        for (int db = 0; db < 4; ++db)
#pragma unroll
            for (int r = 0; r < 16; ++r) o[db][r] = 0.f;
        float mrun = -1e30f, lsum = 0.f;
        for (int t = 0; t < KVLEN / 64; ++t) {
            const bool more = (t + 1 < KVLEN / 64);
            if (more) { const bf16_t* kp = ksrc + (size_t)(t + 1) * 64 * 1024; const bf16_t* vp = vsrc + (t + 1) * 64;
                kr0 = *(const u32x4*)(kp); kr1 = *(const u32x4*)(kp + 32 * 1024); vr0 = *(const u32x4*)(vp); vr1 = *(const u32x4*)(vp + (size_t)64 * KVLEN); }
            LAS unsigned char* bufp = lds + (t & 1) * BUF;
            f32x16 st[2];
#pragma unroll
            for (int kb = 0; kb < 2; ++kb) {
#pragma unroll
                for (int r = 0; r < 16; ++r) st[kb][r] = 0.f;
#pragma unroll
                for (int ds = 0; ds < 4; ++ds) { const bf16x8 a = *(const LAS bf16x8*)(bufp + kfo + kb * 32 * KROWB + ds * 32); st[kb] = MFMA32(a, qf[ds], st[kb]); }
            }
            float mx = st[0][0];
#pragma unroll
            for (int r = 1; r < 16; ++r) mx = fmaxf(mx, st[0][r]);
#pragma unroll
            for (int r = 0; r < 16; ++r) mx = fmaxf(mx, st[1][r]);
            mx = fmaxf(mx, __shfl_xor(mx, 32));
            if (__any(mx > mrun + 8.f)) {
                const float mn = fmaxf(mrun, mx); const float al = __builtin_amdgcn_exp2f(mrun - mn); lsum *= al; mrun = mn;
#pragma unroll
                for (int db = 0; db < 4; ++db)
#pragma unroll
                    for (int r = 0; r < 16; ++r) o[db][r] *= al;
            }
            float ps = 0.f;
#pragma unroll
            for (int kb = 0; kb < 2; ++kb)
#pragma unroll
                for (int r = 0; r < 16; ++r) { const float p = __builtin_amdgcn_exp2f(st[kb][r] - mrun); st[kb][r] = p; ps += p; }
            lsum += ps;
#pragma unroll
            for (int kb = 0; kb < 2; ++kb)
#pragma unroll
                for (int s = 0; s < 2; ++s) {
                    u32x4 pw; pw.x = pk2(st[kb][8 * s + 0], st[kb][8 * s + 1]); pw.y = pk2(st[kb][8 * s + 2], st[kb][8 * s + 3]); pw.z = pk2(st[kb][8 * s + 4], st[kb][8 * s + 5]); pw.w = pk2(st[kb][8 * s + 6], st[kb][8 * s + 7]);
                    const bf16x8 pb = __builtin_bit_cast(bf16x8, pw);
#pragma unroll
                    for (int db = 0; db < 4; ++db) { const bf16x8 a = *(const LAS bf16x8*)(bufp + vfo + db * 32 * VROWB + kb * 64 + s * 32); o[db] = MFMA32(a, pb, o[db]); }
                }
            if (more) { LAS unsigned char* nb = lds + ((t + 1) & 1) * BUF;
                *(LAS u32x4*)(nb + kdst) = kr0; *(LAS u32x4*)(nb + kdst + 32 * KROWB) = kr1; *(LAS u32x4*)(nb + vdst) = vr0; *(LAS u32x4*)(nb + vdst + 64 * VROWB) = vr1; }
            __syncthreads();
        }
        lsum += __shfl_xor(lsum, 32);
        const float inv = 1.f / lsum;
        LAS float* xp = (LAS float*)(lds + XCH_OFF) + ((w & 3) * 64) * 64 + lane;
        if (map == 1) {
#pragma unroll
            for (int db = 0; db < 4; ++db)
#pragma unroll
                for (int r = 0; r < 16; ++r) xp[(db * 16 + r) * 64] = o[db][r] * inv;
        }
        __syncthreads();
        if (map == 0) {
            float ss = 0.f;
#pragma unroll
            for (int db = 0; db < 4; ++db)
#pragma unroll
                for (int r = 0; r < 16; ++r) { const float v = o[db][r] * inv - lam * xp[(db * 16 + r) * 64]; o[db][r] = v; ss += v * v; }
            ss += __shfl_xor(ss, 32);
            const float rstd = rsqrtf(ss * (1.f / 128.f) + 1e-6f) * 0.8f;
            bf16_t* op = O + (size_t)qrow * 1024 + h * 128;
#pragma unroll
            for (int db = 0; db < 4; ++db)
#pragma unroll
                for (int r4 = 0; r4 < 4; ++r4) { const int d0 = 32 * db + 8 * r4 + 4 * hi; const f32x4 gv = *(const f32x4*)(subln + d0); f32x4 v;
                    v[0] = o[db][4 * r4 + 0] * rstd * gv[0]; v[1] = o[db][4 * r4 + 1] * rstd * gv[1]; v[2] = o[db][4 * r4 + 2] * rstd * gv[2]; v[3] = o[db][4 * r4 + 3] * rstd * gv[3];
                    *(u32x2*)(op + d0) = pk4(v); }
        }
    }
}
}

struct Args { const float* in[30]; float* out; unsigned char* ws; int ph_lo, ph_hi, seg, pad; };

DI void transpose_item(const float* W, int K, int Nsrc, bf16_t* WT, int dest_n0, int src_n0, int k0, LAS float* scr, int lane) {
#pragma unroll 8
    for (int i = 0; i < 32; ++i) { const int kk = 2 * i + (lane >> 5); scr[kk * 33 + (lane & 31)] = W[(size_t)(k0 + kk) * Nsrc + src_n0 + (lane & 31)]; }
    asm volatile("s_waitcnt lgkmcnt(0)" ::: "memory");
    const int c = lane & 7;
#pragma unroll
    for (int j = 0; j < 4; ++j) { const int n = (lane >> 3) + 8 * j; const LAS float* s = scr + (8 * c) * 33 + n;
        u32x4 o; o.x = pk2(s[0 * 33], s[1 * 33]); o.y = pk2(s[2 * 33], s[3 * 33]); o.z = pk2(s[4 * 33], s[5 * 33]); o.w = pk2(s[6 * 33], s[7 * 33]);
        *(u32x4*)(WT + (size_t)(dest_n0 + n) * K + k0 + 8 * c) = o; }
    asm volatile("s_waitcnt lgkmcnt(0)" ::: "memory");
}

DI void mod_item(LAS unsigned char* lds, const float* cvec, const float* cctx, const float* wada, const float* bada, float* mod, int it) {
    const int tid = threadIdx.x, lane = tid & 63, w = tid >> 6;
    LAS float* sl = (LAS float*)lds + w * (17 * 256);
    for (int idx = lane; idx < 17 * 256; idx += 64) { const int r = idx >> 8, kk = idx & 255; const float cv = (r < 16) ? cvec[r * DM + 256 * w + kk] : cctx[256 * w + kk]; sl[idx] = cv * sigmoidf_(cv); }
    asm volatile("s_waitcnt lgkmcnt(0)" ::: "memory");
    const int col = it * 64 + lane;
    float acc[17];
#pragma unroll
    for (int r = 0; r < 17; ++r) acc[r] = 0.f;
    const float* wp = wada + (size_t)(256 * w) * NMOD + col;
    for (int kk = 0; kk < 256; kk += 8) {
        float wv[8];
#pragma unroll
        for (int e = 0; e < 8; ++e) wv[e] = wp[(size_t)(kk + e) * NMOD];
#pragma unroll
        for (int r = 0; r < 17; ++r) { const f32x4 s0 = *(const LAS f32x4*)(sl + r * 256 + kk), s1 = *(const LAS f32x4*)(sl + r * 256 + kk + 4);
            acc[r] += s0[0] * wv[0] + s0[1] * wv[1] + s0[2] * wv[2] + s0[3] * wv[3] + s1[0] * wv[4] + s1[1] * wv[5] + s1[2] * wv[6] + s1[3] * wv[7]; }
    }
    __syncthreads();
    LAS float* red = (LAS float*)lds;
#pragma unroll
    for (int r = 0; r < 17; ++r) red[(w * 17 + r) * 64 + lane] = acc[r];
    __syncthreads();
    for (int idx = tid; idx < 17 * 64; idx += NTHREADS) { const int r = idx >> 6, l = idx & 63; float s = bada[it * 64 + l];
#pragma unroll
        for (int ww = 0; ww < 8; ++ww) s += red[(ww * 17 + r) * 64 + l];
        mod[(size_t)r * NMOD + it * 64 + l] = s; }
    __syncthreads();
}

DI void transpose_tile64(const float* W, int K, int Nsrc, bf16_t* WT, int dest_n0, int src_n0, int k0, LAS float* scr, int lane) {
    f32x4 v[16];
    const float* src = W + (size_t)(k0 + (lane >> 4)) * Nsrc + src_n0 + (lane & 15) * 4;
#pragma unroll
    for (int i = 0; i < 16; ++i) v[i] = *(const f32x4*)(src + (size_t)(4 * i) * Nsrc);
#pragma unroll
    for (int i = 0; i < 16; ++i) { LAS float* p = scr + (4 * i + (lane >> 4)) * 65 + (lane & 15) * 4; p[0] = v[i][0]; p[1] = v[i][1]; p[2] = v[i][2]; p[3] = v[i][3]; }
    asm volatile("s_waitcnt lgkmcnt(0)" ::: "memory");
    const int c = lane & 7;
#pragma unroll
    for (int j = 0; j < 8; ++j) { const int n = (lane >> 3) + 8 * j; const LAS float* s = scr + (8 * c) * 65 + n;
        u32x4 o; o.x = pk2(s[0 * 65], s[1 * 65]); o.y = pk2(s[2 * 65], s[3 * 65]); o.z = pk2(s[4 * 65], s[5 * 65]); o.w = pk2(s[6 * 65], s[7 * 65]);
        *(u32x4*)(WT + (size_t)(dest_n0 + n) * K + k0 + 8 * c) = o; }
    asm volatile("s_waitcnt lgkmcnt(0)" ::: "memory");
}

DI void mod_item128(LAS unsigned char* lds, const float* cvec, const float* cctx, const float* wada, const float* bada, float* mod, int it) {
    const int tid = threadIdx.x, lane = tid & 63, w = tid >> 6;
    LAS float* sl = (LAS float*)lds + w * (17 * 256);
    for (int idx = lane; idx < 17 * 256; idx += 64) { const int r = idx >> 8, kk = idx & 255; const float cv = (r < 16) ? cvec[r * DM + 256 * w + kk] : cctx[256 * w + kk]; sl[idx] = cv * sigmoidf_(cv); }
    asm volatile("s_waitcnt lgkmcnt(0)" ::: "memory");
    const int col = it * 128 + 2 * lane;
    float a0[17], a1[17];
#pragma unroll
    for (int r = 0; r < 17; ++r) { a0[r] = 0.f; a1[r] = 0.f; }
    const float* wp = wada + (size_t)(256 * w) * NMOD + col;
    for (int kk = 0; kk < 256; kk += 32) {
        f32x2_t wv[32];
#pragma unroll
        for (int e = 0; e < 32; ++e) wv[e] = *(const f32x2_t*)(wp + (size_t)(kk + e) * NMOD);
#pragma unroll
        for (int r = 0; r < 17; ++r) {
#pragma unroll
            for (int q = 0; q < 8; ++q) { const f32x4 s4 = *(const LAS f32x4*)(sl + r * 256 + kk + 4 * q);
                a0[r] += s4[0] * wv[4 * q][0] + s4[1] * wv[4 * q + 1][0] + s4[2] * wv[4 * q + 2][0] + s4[3] * wv[4 * q + 3][0];
                a1[r] += s4[0] * wv[4 * q][1] + s4[1] * wv[4 * q + 1][1] + s4[2] * wv[4 * q + 2][1] + s4[3] * wv[4 * q + 3][1]; }
        }
    }
    __syncthreads();
    LAS float* red = (LAS float*)lds;
#pragma unroll
    for (int r = 0; r < 17; ++r) { red[(w * 17 + r) * 128 + 2 * lane] = a0[r]; red[(w * 17 + r) * 128 + 2 * lane + 1] = a1[r]; }
    __syncthreads();
    for (int idx = tid; idx < 17 * 128; idx += NTHREADS) { const int r = idx >> 7, c = idx & 127; float s = bada[it * 128 + c];
#pragma unroll
        for (int ww = 0; ww < 8; ++ww) s += red[(ww * 17 + r) * 128 + c];
        mod[(size_t)r * NMOD + it * 128 + c] = s; }
}

DI void ssm_coef_item(LAS unsigned char* lds, const float* const* in, bf16_t* Bt3, bf16_t* Bt1, float* lamT, int g) {
    const int tid = threadIdx.x;
    LAS float* Lam = (LAS float*)lds;
    LAS float* Bb = Lam + 2 * 33 * 64 * 2;
    LAS float* Cm = Bb + 2 * 64 * 16 * 2;
    LAS float* Km = Cm + 2 * 16 * 130;
    const float* a_re = in[8]; const float* a_im = in[9]; const float* log_dt = in[10]; const float* b_re = in[11]; const float* b_im = in[12];
    const float* c_re = in[13]; const float* c_im = in[14]; const float* dsk = in[15];
    if (tid < 128) {
        const int d = tid >> 6, p = tid & 63;
        const double dt = exp((double)log_dt[d * 64 + g]); const double lr = (double)a_re[(d * 64 + g) * 64 + p], li = (double)a_im[(d * 64 + g) * 64 + p];
        const double zr = lr * dt, zi = li * dt; const double mag = exp(zr); double rev = zi * 0.15915494309189535; rev -= floor(rev + 0.5); const double ang = rev * 6.283185307179586;
        const double er = mag * cos(ang), ei = mag * sin(ang);
        double pr = 1.0, pi = 0.0;
        for (int j = 0; j <= 32; ++j) { Lam[((d * 33 + j) * 64 + p) * 2] = (float)pr; Lam[((d * 33 + j) * 64 + p) * 2 + 1] = (float)pi; const double nr = pr * er - pi * ei, ni = pr * ei + pi * er; pr = nr; pi = ni; }
        const double den = lr * lr + li * li; const double e1 = er - 1.0; const double fr_ = (e1 * lr + ei * li) / den, fi_ = (ei * lr - e1 * li) / den;
        const float* brp = b_re + ((size_t)(d * 64 + g) * 64 + p) * 16; const float* bip = b_im + ((size_t)(d * 64 + g) * 64 + p) * 16;
#pragma unroll
        for (int c = 0; c < 16; ++c) { const double br = (double)brp[c], bi = (double)bip[c]; Bb[((d * 64 + p) * 16 + c) * 2] = (float)(fr_ * br - fi_ * bi); Bb[((d * 64 + p) * 16 + c) * 2 + 1] = (float)(fr_ * bi + fi_ * br); }
    }
    for (int idx = tid; idx < 2 * 16 * 64; idx += NTHREADS) { const int p = idx & 63, c = (idx >> 6) & 15, d = idx >> 10;
        Cm[(d * 16 + c) * 130 + p * 2] = c_re[((d * 64 + g) * 16 + c) * 64 + p]; Cm[(d * 16 + c) * 130 + p * 2 + 1] = c_im[((d * 64 + g) * 16 + c) * 64 + p]; }
    __syncthreads();
    {
        const int q4 = tid & 3, c = (tid >> 2) & 15, djl = tid >> 6;
        for (int rnd = 0; rnd < 8; ++rnd) {
            const int dj = rnd * 8 + djl, d = dj >> 5, j = dj & 31;
            float a0 = 0.f, a1 = 0.f, a2 = 0.f, a3 = 0.f;
            const LAS float* cmp = Cm + (d * 16 + c) * 130; const LAS float* lmp = Lam + ((d * 33 + j) * 64) * 2; const LAS float* bbp = Bb + (d * 64 * 16 + 4 * q4) * 2;
#pragma unroll 4
            for (int p = 0; p < 64; ++p) {
                const f32x2_t cv = *(const LAS f32x2_t*)(cmp + p * 2), lv = *(const LAS f32x2_t*)(lmp + p * 2);
                const f32x4 b01 = *(const LAS f32x4*)(bbp + p * 32), b23 = *(const LAS f32x4*)(bbp + p * 32 + 4);
                const float vr = cv[0] * lv[0] - cv[1] * lv[1], vi = cv[0] * lv[1] + cv[1] * lv[0];
                a0 += vr * b01[0] - vi * b01[1]; a1 += vr * b01[2] - vi * b01[3]; a2 += vr * b23[0] - vi * b23[1]; a3 += vr * b23[2] - vi * b23[3];
            }
            *(LAS f32x4*)(Km + ((d * 32 + j) * 16 + c) * 16 + 4 * q4) = (f32x4){a0, a1, a2, a3};
        }
    }
    __syncthreads();
    bf16_t* B3 = Bt3 + (size_t)g * 512 * UK;
    for (int idx = tid; idx < 512 * 96; idx += NTHREADS) {
        const int n = idx / 96, k0 = (idx % 96) * 8; const int t = n >> 4, c = n & 15;
        float v[8];
        if (k0 < 512) {
            const int s = k0 >> 4, c0 = k0 & 15;
#pragma unroll
            for (int e = 0; e < 8; ++e) { const int cp = c0 + e; float x;
                if (s < t) x = Km[((0 * 32 + (t - s)) * 16 + c) * 16 + cp];
                else if (s > t) x = Km[((1 * 32 + (s - t)) * 16 + c) * 16 + cp];
                else x = Km[(c) * 16 + cp] + Km[((32) * 16 + c) * 16 + cp] + (c == cp ? dsk[g * 16 + c] : 0.f);
                v[e] = x; }
        } else {
            const int kk = k0 - 512, sec = kk >> 6, p0 = kk & 63, d = sec >> 1, part = sec & 1; const int jj = d == 0 ? t + 1 : TCH - t;
#pragma unroll
            for (int e = 0; e < 8; ++e) { const int p = p0 + e;
                const float cr = Cm[(d * 16 + c) * 130 + p * 2], ci = Cm[(d * 16 + c) * 130 + p * 2 + 1];
                const float lr = Lam[((d * 33 + jj) * 64 + p) * 2], li = Lam[((d * 33 + jj) * 64 + p) * 2 + 1];
                v[e] = part == 0 ? (cr * lr - ci * li) : -(cr * li + ci * lr); }
        }
        u32x4 o; o.x = pk2(v[0], v[1]); o.y = pk2(v[2], v[3]); o.z = pk2(v[4], v[5]); o.w = pk2(v[6], v[7]);
        *(u32x4*)(B3 + (size_t)n * UK + k0) = o;
    }
    bf16_t* B1 = Bt1 + (size_t)g * 256 * 512;
    for (int idx = tid; idx < 256 * 64; idx += NTHREADS) {
        const int n = idx >> 6, k0 = (idx & 63) * 8; const int s = k0 >> 4, c0 = k0 & 15; const int d = n >> 7, part = (n >> 6) & 1, p = n & 63;
        const int ee = d == 0 ? (TCH - 1 - s) : s;
        const float lr = Lam[((d * 33 + ee) * 64 + p) * 2], li = Lam[((d * 33 + ee) * 64 + p) * 2 + 1];
        float v[8];
#pragma unroll
        for (int e = 0; e < 8; ++e) { const float br = Bb[((d * 64 + p) * 16 + c0 + e) * 2], bi = Bb[((d * 64 + p) * 16 + c0 + e) * 2 + 1]; v[e] = part == 0 ? (lr * br - li * bi) : (lr * bi + li * br); }
        u32x4 o; o.x = pk2(v[0], v[1]); o.y = pk2(v[2], v[3]); o.z = pk2(v[4], v[5]); o.w = pk2(v[6], v[7]);
        *(u32x4*)(B1 + (size_t)n * 512 + k0) = o;
    }
    for (int idx = tid; idx < 128; idx += NTHREADS) { const int d = idx >> 6, p = idx & 63; lamT[((g * 2 + d) * 64 + p) * 2] = Lam[((d * 33 + 32) * 64 + p) * 2]; lamT[((g * 2 + d) * 64 + p) * 2 + 1] = Lam[((d * 33 + 32) * 64 + p) * 2 + 1]; }
    __syncthreads();
}

DI void normmod_row(const float* xr, const float* gv, const float* sh, const float* sc, bf16_t* orow, int lane) {
    f32x4 v[8]; float ss = 0.f;
#pragma unroll
    for (int j = 0; j < 8; ++j) { v[j] = *(const f32x4*)(xr + 4 * lane + 256 * j); ss += (v[j][0] * v[j][0] + v[j][1] * v[j][1]) + (v[j][2] * v[j][2] + v[j][3] * v[j][3]); }
    const float rstd = rsqrtf(wave_sum(ss) * (1.f / DM) + 1e-6f);
#pragma unroll
    for (int j = 0; j < 8; ++j) { const int c = 4 * lane + 256 * j; const f32x4 g4 = *(const f32x4*)(gv + c), s4 = *(const f32x4*)(sh + c), c4 = *(const f32x4*)(sc + c);
        const f32x4 y = (v[j] * rstd * g4) * (c4 + 1.f) + s4; *(u32x2*)(orow + c) = pk4(y); }
}

constexpr int NPH = 14;
__global__ void __launch_bounds__(NTHREADS, 2) fwd_kernel(Args args) {
    extern __shared__ __attribute__((aligned(16))) unsigned char lds_raw[];
    LAS unsigned char* lds = (LAS unsigned char*)lds_raw;
    cg::grid_group grid = cg::this_grid();
    const int tid = threadIdx.x, lane = tid & 63, wave = __builtin_amdgcn_readfirstlane(tid >> 6);
    const int G = gridDim.x, cb = blockIdx.x;
    const int gw = cb * 8 + wave, NGW = G * 8;
    unsigned char* ws = args.ws;
    const float* x = args.in[0]; float* out = args.out;
    bf16_t* Wt_in = (bf16_t*)(ws + WS_WIN); bf16_t* Wt_glu = (bf16_t*)(ws + WS_WGLU); bf16_t* Wt_ps = (bf16_t*)(ws + WS_WPS); bf16_t* Wt_pa = (bf16_t*)(ws + WS_WPA);
    bf16_t* Wt_out = (bf16_t*)(ws + WS_WOUT); bf16_t* Wt_fi = (bf16_t*)(ws + WS_WFI); bf16_t* Wt_fo = (bf16_t*)(ws + WS_WFO);
    bf16_t* Bt3 = (bf16_t*)(ws + WS_BT3); bf16_t* Bt1 = (bf16_t*)(ws + WS_BT1);
    float* mod = (float*)(ws + WS_MOD); float* rope = (float*)(ws + WS_ROPE); float* lamS = (float*)(ws + WS_LAMS); float* lamT = (float*)(ws + WS_LAMT);
    bf16_t* Hb = (bf16_t*)(ws + WS_H); bf16_t* Oatt = (bf16_t*)(ws + WS_OATT); bf16_t* Yssm = (bf16_t*)(ws + WS_YSSM); bf16_t* H2 = (bf16_t*)(ws + WS_H2);
    bf16_t* Ug = (bf16_t*)(ws + WS_UG); float* Sst = (float*)(ws + WS_S); bf16_t* Vt = (bf16_t*)(ws + WS_VT); bf16_t* tmp = (bf16_t*)(ws + WS_TMP); bf16_t* Hid = (bf16_t*)(ws + WS_HID);
    bf16_t* Qb = (bf16_t*)(ws + WS_Q); bf16_t* Zb = (bf16_t*)(ws + WS_Z); bf16_t* Kb = (bf16_t*)(ws + WS_K); bf16_t* Mg = (bf16_t*)(ws + WS_MERGED);
    bf16_t* SGs = (bf16_t*)(ws + WS_SGS); bf16_t* SGa = (bf16_t*)(ws + WS_SGA);
    const int lo = args.ph_lo, hi_ph = args.ph_hi;
#define IN(k) (lo <= (k) && (k) < hi_ph)
#define SEAM(k) do { if (IN(k) && IN((k) + 1)) grid.sync(); } while (0)

    if (IN(0)) {
        if (cb == 0) {
            for (int idx = tid; idx < 64 * 16; idx += NTHREADS) { const int pos = idx >> 4, f = idx & 15; const float inv = powf(10000.f, -(float)f / 16.f); const float a = (float)pos * inv; rope[idx * 2] = cosf(a); rope[idx * 2 + 1] = sinf(a); }
            if (tid == 0) { float s1 = 0.f, s2 = 0.f; for (int i = 0; i < 64; ++i) { s1 += args.in[18][i] * args.in[19][i]; s2 += args.in[20][i] * args.in[21][i]; } lamS[0] = expf(s1) - expf(s2) + 0.2f; }
        }
        {
            constexpr int T0 = 32 * 128, T1 = 16 * 16, T2 = 16 * 32, T3 = 16 * 32, T4 = 32 * 32, T5 = 32 * 176, T6 = 88 * 32;
            constexpr int NITEMS = 64 + 96 + (T0 + T1 + T2 + T3 + T4 + T5 + T6) / 8;
            LAS int* qslot = (LAS int*)(lds + LDS_BYTES - 16);
            int* ctr = (int*)(ws + WS_CTR) + args.seg * 16;
            LAS float* scr = (LAS float*)(lds + wave * 16640);
            for (;;) {
                __syncthreads();
                if (tid == 0) *qslot = atomicAdd(ctr, 1);
                __syncthreads();
                const int it = *qslot;
                if (it >= NITEMS) break;
                if (it < 64) { if (args.pad & 1) ssm_coef_item(lds, args.in, Bt3, Bt1, lamT, it); }
                else if (it < 160) { if (args.pad & 2) mod_item128(lds, args.in[1], args.in[3], args.in[4], args.in[5], mod, it - 64); }
                else if (args.pad & 4) {
                    int r = (it - 160) * 8 + wave;
                    if (r < T0) { const int nblk = 128, kb = r / nblk, nb = r % nblk; transpose_tile64(args.in[7], DM, DIN, Wt_in, nb * 64, nb * 64, kb * 64, scr, lane); }
                    else if ((r -= T0) < T1) { const int nblk = 16, kb = r / nblk, nb = r % nblk; transpose_tile64(args.in[16], 1024, 1024, Wt_glu, nb * 64, nb * 64, kb * 64, scr, lane); }
                    else if ((r -= T1) < T2) { const int nblk = 32, kb = r / nblk, nb = r % nblk; transpose_tile64(args.in[23], 1024, DM, Wt_ps, nb * 64, nb * 64, kb * 64, scr, lane); }
                    else if ((r -= T2) < T3) { const int nblk = 32, kb = r / nblk, nb = r % nblk; transpose_tile64(args.in[24], 1024, DM, Wt_pa, nb * 64, nb * 64, kb * 64, scr, lane); }
                    else if ((r -= T3) < T4) { const int nblk = 32, kb = r / nblk, nb = r % nblk; transpose_tile64(args.in[25], DM, DM, Wt_out, nb * 64, nb * 64, kb * 64, scr, lane); }
                    else if ((r -= T4) < T5) { const int nblk = 176, kb = r / nblk, nb = r % nblk; const int n0 = nb * 64, tile = n0 >> 8, within = n0 & 255;
                        const int src = within < 128 ? tile * 128 + within : DFF + tile * 128 + (within - 128);
                        transpose_tile64(args.in[27], DM, 2 * DFF, Wt_fi, n0, src, kb * 64, scr, lane); }
                    else { r -= T5; const int nblk = 32, kb = r / nblk, nb = r % nblk; transpose_tile64(args.in[28], DFF, DM, Wt_fo, nb * 64, nb * 64, kb * 64, scr, lane); }
                }
            }
        }
    }
    SEAM(0);
    if (IN(1)) {
        for (int row = gw; row < MTOT; row += NGW) {
            const float* xr = row < MLAT ? x + (size_t)row * DM : args.in[2] + (size_t)(row - MLAT) * DM;
            const float* mr = mod + (size_t)(row < MLAT ? (row >> 11) : 16) * NMOD;
            normmod_row(xr, args.in[6], mr, mr + DM, Hb + (size_t)row * DM, lane);
        }
    }
    SEAM(1);
    if (IN(2)) {
        pg8::Gemm g{Hb, Wt_in, DM, DM, DM, 0, 0};
        pg8::EpiInProj E{Ug, Qb, Kb, Vt, SGs, SGa, rope};
        { pg8::StaticOrder S; S.init(MLAT / 256, DIN / 256, 1, G, cb); pg8::gemm_phase(lds, g, S, E); }
        { pg8::CtxOrder S{G, cb}; pg8::gemm_phase(lds, g, S, E); }
    }
    SEAM(2);
    if (IN(3)) {
        pg8::Gemm g{Ug, Bt1, UK, 512, 512, (size_t)UROWS_PAD * UK, (size_t)256 * 512};
        pg8::EpiSsm1 E{Sst};
        pg8::StaticOrder S; S.init(UROWS_PAD / 256, 1, 64, G, cb); pg8::gemm_phase(lds, g, S, E);
    }
    SEAM(3);
    if (IN(4)) {
        for (int idx = cb * NTHREADS + tid; idx < NB * 64 * 2 * 64; idx += G * NTHREADS) {
            const int p = idx & 63, d = (idx >> 6) & 1, g = (idx >> 7) & 63, b = idx >> 13;
            const float lr = lamT[((g * 2 + d) * 64 + p) * 2], li = lamT[((g * 2 + d) * 64 + p) * 2 + 1];
            const float* Sg = Sst + (size_t)g * UROWS_PAD * 256 + d * 128 + p;
            bf16_t* Up = Ug + (size_t)g * (UROWS_PAD * UK) + 512 + d * 128 + p;
            float hr = 0.f, hi = 0.f;
#pragma unroll
            for (int kk = 0; kk < 8; ++kk) { const int k = d ? 7 - kk : kk; const float* sp = Sg + (size_t)(1024 + b * 8 + k) * 256; const float sr = sp[0], si = sp[64];
                const float nr = lr * hr - li * hi + sr, ni = lr * hi + li * hr + si; hr = nr; hi = ni; }
#pragma unroll 8
            for (int kk = 0; kk < 64; ++kk) { const int k = d ? 63 - kk : kk; const int row = b * 64 + k; bf16_t* up = Up + (size_t)row * UK; up[0] = f2bf1(hr); up[64] = f2bf1(hi);
                const float* sp = Sg + (size_t)row * 256; const float sr = sp[0], si = sp[64];
                const float nr = lr * hr - li * hi + sr, ni = lr * hi + li * hr + si; hr = nr; hi = ni; }
        }
        att::attn_phase(lds, Qb, Kb, Vt, Oatt, args.in[22], lamS, G, cb);
    }
    SEAM(4);
    if (IN(5)) {
        pg8::Gemm g{Ug, Bt3, UK, UK, UK, (size_t)UROWS_PAD * UK, (size_t)512 * UK};
        pg8::EpiSsm3 E{Zb};
        pg8::StaticOrder S; S.init(4, 2, 64, G, cb); pg8::gemm_phase(lds, g, S, E);
    }
    SEAM(5);
    if (IN(6)) {
        pg8::Gemm g{Zb, Wt_glu, 1024, 1024, 1024, 0, 0};
        pg8::EpiGlu E{Zb, args.in[17], Yssm};
        pg8::StaticOrder S; S.init(MLAT / 256, 4, 1, G, cb); pg8::gemm_phase(lds, g, S, E);
    }
    SEAM(6);
    if (IN(7)) {
        pg8::Gemm g{Yssm, Wt_ps, 1024, 1024, 1024, 0, 0};
        pg8::EpiProj1 E{SGs, tmp};
        pg8::StaticOrder S; S.init(MLAT / 256, 8, 1, G, cb); pg8::gemm_phase(lds, g, S, E);
    }
    SEAM(7);
    if (IN(8)) {
        pg8::Gemm g{Oatt, Wt_pa, 1024, 1024, 1024, 0, 0};
        pg8::EpiProj2 E{SGa, tmp, Mg};
        pg8::StaticOrder S; S.init(MLAT / 256, 8, 1, G, cb); pg8::gemm_phase(lds, g, S, E);
    }
    SEAM(8);
    if (IN(9)) {
        pg8::Gemm g{Mg, Wt_out, DM, DM, DM, 0, 0};
        pg8::EpiResid E{x, mod + 2 * DM, out};
        pg8::StaticOrder S; S.init(MLAT / 256, 8, 1, G, cb); pg8::gemm_phase(lds, g, S, E);
    }
    SEAM(9);
    if (IN(10)) {
        for (int row = gw; row < MLAT; row += NGW) { const float* mr = mod + (size_t)(row >> 11) * NMOD; normmod_row(out + (size_t)row * DM, args.in[26], mr + 3 * DM, mr + 4 * DM, H2 + (size_t)row * DM, lane); }
    }
    SEAM(10);
    if (IN(11)) {
        pg8::Gemm g{H2, Wt_fi, DM, DM, DM, 0, 0};
        pg8::EpiFfnIn E{Hid};
        pg8::StaticOrder S; S.init(MLAT / 256, 44, 1, G, cb); pg8::gemm_phase(lds, g, S, E);
    }
    SEAM(11);
    if (IN(12)) {
        pg8::Gemm g{Hid, Wt_fo, DFF, DFF, DFF, 0, 0};
        pg8::EpiResid E{out, mod + 5 * DM, out};
        pg8::StaticOrder S; S.init(MLAT / 256, 8, 1, G, cb); pg8::gemm_phase(lds, g, S, E);
    }
    SEAM(12);
    if (IN(13)) {
        const float* gf = args.in[29];
        for (int row = gw; row < MLAT; row += NGW) {
            float* xr = out + (size_t)row * DM; f32x4 v[8]; float ss = 0.f;
#pragma unroll
            for (int j = 0; j < 8; ++j) { v[j] = *(const f32x4*)(xr + 4 * lane + 256 * j); ss += (v[j][0] * v[j][0] + v[j][1] * v[j][1]) + (v[j][2] * v[j][2] + v[j][3] * v[j][3]); }
            const float rstd = rsqrtf(wave_sum(ss) * (1.f / DM) + 1e-6f);
#pragma unroll
            for (int j = 0; j < 8; ++j) { const int c = 4 * lane + 256 * j; const f32x4 g4 = *(const f32x4*)(gf + c); *(f32x4*)(xr + c) = v[j] * rstd * g4; }
        }
    }
#undef IN
#undef SEAM
}

#ifndef SEGMENTS
#define SEGMENTS 0, 14, 7, -1
#endif
extern "C" void kernel_launch(void* const* d_in, const int* in_sizes, int n_in, void* d_out, int out_size, void* d_ws, size_t ws_size, hipStream_t stream) {
    static int grid = 0;
    if (grid == 0) {
        if (n_in != 30 || out_size != MLAT * DM || ws_size < WS_END) { fprintf(stderr, "kernel_launch: unexpected shapes (n_in %d out %d ws %zu)\n", n_in, out_size, ws_size); grid = -1; return; }
        int dev = 0, cus = 0, per_cu = 0;
        (void)hipGetDevice(&dev);
        (void)hipDeviceGetAttribute(&cus, hipDeviceAttributeMultiprocessorCount, dev);
        if (hipFuncSetAttribute((const void*)fwd_kernel, hipFuncAttributeMaxDynamicSharedMemorySize, LDS_BYTES) != hipSuccess) { fprintf(stderr, "kernel_launch: hipFuncSetAttribute failed\n"); grid = -1; return; }
        if (hipOccupancyMaxActiveBlocksPerMultiprocessor(&per_cu, (const void*)fwd_kernel, NTHREADS, LDS_BYTES) != hipSuccess || per_cu < 1) { fprintf(stderr, "kernel_launch: occupancy query says %d\n", per_cu); per_cu = 1; }
        (void)hipGetLastError();
        grid = cus * per_cu;
        fprintf(stderr, "kernel_launch: grid %d (cus %d x %d)\n", grid, cus, per_cu);
    }
    if (grid < 0) return;
    Args a{};
    for (int i = 0; i < 30; ++i) a.in[i] = (const float*)d_in[i];
    a.out = (float*)d_out; a.ws = (unsigned char*)d_ws;
    (void)hipMemsetAsync((unsigned char*)d_ws + WS_CTR, 0, 256, stream);
    const int segs[] = {SEGMENTS};
    for (int si = 0; si + 2 < (int)(sizeof(segs) / sizeof(int)); si += 3) {
        a.ph_lo = segs[si]; a.ph_hi = segs[si + 1]; a.seg = si / 3; a.pad = segs[si + 2];
        void* kargs[] = {&a};
        hipError_t e = hipLaunchCooperativeKernel((const void*)fwd_kernel, dim3(grid), dim3(NTHREADS), kargs, LDS_BYTES, stream);
        if (e != hipSuccess) fprintf(stderr, "kernel_launch: cooperative launch failed: %s (grid %d)\n", hipGetErrorString(e), grid);
    }
}
```

```cpp
#include <hip/hip_runtime.h>
#include <hip/hip_cooperative_groups.h>
#include <cstdio>
#include <cstdint>
namespace cg = cooperative_groups;

#define LAS __attribute__((address_space(3)))
#define DI __device__ __forceinline__
typedef unsigned short bf16_t;
typedef short bf16x8 __attribute__((ext_vector_type(8)));
typedef float f32x4 __attribute__((ext_vector_type(4)));
typedef float f32x16 __attribute__((ext_vector_type(16)));
typedef unsigned u32x4 __attribute__((ext_vector_type(4)));
typedef unsigned u32x2 __attribute__((ext_vector_type(2)));
typedef float f32x2_t __attribute__((ext_vector_type(2)));
typedef __bf16 bf16x2_t __attribute__((ext_vector_type(2)));

constexpr int DM = 2048, NB = 16, SEQ = 2048, LCTX = 256, MLAT = NB * SEQ, MCTX = NB * LCTX, MTOT = MLAT + MCTX;
constexpr int KVLEN = SEQ + LCTX;
constexpr int DFF = 5632, DIN = 8192, NMOD = 6 * DM;
constexpr int TCH = 32;
constexpr int UROWS_PAD = 1280, UK = 768;
constexpr float QSCALE = 0.125f * 1.4426950408889634f;
constexpr int NTHREADS = 512;
constexpr int LDS_BYTES = 147456;

constexpr size_t MiB = 1u << 20;
constexpr size_t WS_WIN = 0, WS_WGLU = 32 * MiB, WS_WPS = 34 * MiB, WS_WPA = 38 * MiB, WS_WOUT = 42 * MiB, WS_WFI = 50 * MiB, WS_WFO = 94 * MiB;
constexpr size_t WS_BT3 = 116 * MiB, WS_BT1 = 164 * MiB, WS_MOD = 180 * MiB, WS_ROPE = 181 * MiB, WS_LAMS = 181 * MiB + 16384, WS_LAMT = 181 * MiB + 32768, WS_CTR = 181 * MiB + 131072;
constexpr size_t WS_H = 182 * MiB, WS_OATT = 182 * MiB, WS_YSSM = 246 * MiB, WS_H2 = 182 * MiB;
constexpr size_t WS_UG = 326 * MiB, WS_S = 446 * MiB, WS_VT = 526 * MiB, WS_TMP = 326 * MiB, WS_HID = 326 * MiB;
constexpr size_t WS_Q = 598 * MiB, WS_Z = 598 * MiB, WS_K = 662 * MiB, WS_MERGED = 598 * MiB;
constexpr size_t WS_SGS = 734 * MiB, WS_SGA = 862 * MiB, WS_END = 990 * MiB;

DI unsigned pk2(float lo, float hi) { f32x2_t v = {lo, hi}; bf16x2_t b = __builtin_convertvector(v, bf16x2_t); return __builtin_bit_cast(unsigned, b); }
DI u32x2 pk4(f32x4 v) { u32x2 r; r.x = pk2(v[0], v[1]); r.y = pk2(v[2], v[3]); return r; }
DI float bf2f(unsigned h) { return __uint_as_float(h << 16); }
DI f32x4 unpk4(u32x2 w) { f32x4 r; r[0] = bf2f(w.x & 0xffffu); r[1] = bf2f(w.x >> 16); r[2] = bf2f(w.y & 0xffffu); r[3] = bf2f(w.y >> 16); return r; }
DI bf16_t f2bf1(float f) { return (bf16_t)(pk2(f, 0.f) & 0xffffu); }
DI float sigmoidf_(float x) { return __builtin_amdgcn_rcpf(1.f + __expf(-x)); }
DI float wave_sum(float v) {
#pragma unroll
    for (int o = 1; o < 64; o <<= 1) v += __shfl_xor(v, o);
    return v;
}

namespace pg8 {
constexpr int BM = 256, BK = 64, HALF = 128, HTB = HALF * BK * 2, STAGE_BYTES = 8 * HTB, NXCD = 8, WGM = 8;
__host__ __device__ __forceinline__ int lds_byte(int r, int c) { const int st = (r >> 4) * 2 + (c >> 5), rr = r & 15, cc = c & 31, ob = rr * 64 + cc * 2; return st * 1024 + (ob ^ (((ob >> 9) & 1) << 5)); }
__host__ __device__ __forceinline__ int perm32(int rho) { const int n = rho >> 4, i = rho & 15; return 8 * (i >> 2) + 4 * n + (i & 3); }
__host__ __device__ __forceinline__ void stage_rc(int b, int& R, int& C) { const int st = b / 1024, sb = b % 1024, swz = sb ^ (((sb >> 9) & 1) << 5); R = (st >> 1) * 16 + swz / 64; C = (st & 1) * 32 + (swz % 64) / 2; }

struct Unit { int pm, pn, bz; };
struct Gemm { const bf16_t* A; const bf16_t* Bt; int lda, ldb, K; size_t sA, sB; };

struct StaticOrder {
    int nM, nN, nB, nwg, G, c;
    DI void init(int nM_, int nN_, int nB_, int G_, int c_) { nM = nM_; nN = nN_; nB = nB_; nwg = nM_ * nN_; G = G_; c = c_; }
    DI bool next(int i, Unit& u) const {
        const int tot = nwg * nB; const long L = (long)i * G + c; if (L >= tot) return false;
        int wg = (int)L; { const int q = tot / NXCD, r = tot % NXCD, xcd = wg % NXCD, off = wg / NXCD; wg = (xcd < r ? xcd * (q + 1) : r * (q + 1) + (xcd - r) * q) + off; }
        u.bz = wg / nwg; const int wgid = wg % nwg;
        const int nig = WGM * nN, gid = wgid / nig, fm = gid * WGM, gsz = (nM - fm) < WGM ? (nM - fm) : WGM;
        u.pm = fm + ((wgid % nig) % gsz); u.pn = (wgid % nig) / gsz; return true;
    }
};
struct CtxOrder {
    int G, c;
    DI bool next(int i, Unit& u) const {
        const int L = i * G + c; if (L >= 16 * 12) return false;
        u.bz = 0; u.pm = 128 + L / 12; const int j = L % 12; u.pn = j < 4 ? j : j + 4; return true;
    }
};

template <class Epi, class Sched>
DI void gemm_phase(LAS unsigned char* lds, const Gemm g, const Sched& S, const Epi& E) {
    const int tid = threadIdx.x, wid = __builtin_amdgcn_readfirstlane(tid >> 6), lane = tid & 63, wr = wid >> 2, wc = wid & 3, fr = lane & 15, fq = lane >> 4;
    const int K = g.K, nt = K / BK;
    unsigned voffA[2], voffB[2];
#pragma unroll
    for (int i = 0; i < 2; ++i) { int R, C; stage_rc(tid * 16 + i * 8192, R, C); const int Rb = (R & ~31) + perm32(R & 31); voffA[i] = (unsigned)(R * g.lda + C) * 2u; voffB[i] = (unsigned)(Rb * g.ldb + C) * 2u; }
    const size_t kstep = (size_t)(BK * 2);
    const size_t hsA = (size_t)HALF * g.lda * 2, hsB = (size_t)HALF * g.ldb * 2;
    const unsigned ldsw = (unsigned)wid * 1024u;
    const int aoff = lds_byte(wr * 64 + fr, fq * 8), boff = lds_byte(wc * 32 + fr, fq * 8);
#define PG8_SA(b, h) (((b) * 2 + (h)) * HTB)
#define PG8_SB(b, h) ((4 + (b) * 2 + (h)) * HTB)
#define PG8_STAGE(bufoff, gbase, voff) do { _Pragma("unroll") for (int _i = 0; _i < 2; ++_i) \
        __builtin_amdgcn_global_load_lds((const unsigned*)((const char*)(gbase) + (voff)[_i]), (LAS unsigned*)(lds + (bufoff) + ldsw + _i * 8192), 16, 0, 0); } while (0)
#define PG8_LDA(dst, b, h) do { _Pragma("unroll") for (int m = 0; m < 4; ++m) _Pragma("unroll") for (int k = 0; k < 2; ++k) dst[m][k] = *(const LAS bf16x8*)(lds + PG8_SA(b, h) + aoff + m * 2048 + k * 1024); } while (0)
#define PG8_LDB(dst, b, h) do { _Pragma("unroll") for (int n = 0; n < 2; ++n) _Pragma("unroll") for (int k = 0; k < 2; ++k) dst[n][k] = *(const LAS bf16x8*)(lds + PG8_SB(b, h) + boff + n * 2048 + k * 1024); } while (0)
#define PG8_MMA(ai, bj, At, Bt) do { __builtin_amdgcn_s_setprio(1); _Pragma("unroll") for (int m = 0; m < 4; ++m) _Pragma("unroll") for (int n = 0; n < 2; ++n) _Pragma("unroll") for (int k = 0; k < 2; ++k) \
        acc[ai][bj][m][n] = __builtin_amdgcn_mfma_f32_16x16x32_bf16(Bt[n][k], At[m][k], acc[ai][bj][m][n], 0, 0, 0); __builtin_amdgcn_s_setprio(0); } while (0)
#define PG8_WAIT_V(n) asm volatile("s_waitcnt vmcnt(" #n ")" ::: "memory")
#define PG8_WAIT_L(n) asm volatile("s_waitcnt lgkmcnt(" #n ")" ::: "memory")
#define PG8_BAR __builtin_amdgcn_s_barrier()
#define PG8_SCHED __builtin_amdgcn_sched_barrier(0)
#define PG8_UA(u) ((const char*)g.A + ((size_t)(u).bz * g.sA + (size_t)(u).pm * BM * g.lda) * 2)
#define PG8_UB(u) ((const char*)g.Bt + ((size_t)(u).bz * g.sB + (size_t)(u).pn * BM * g.ldb) * 2)
    Unit cur, nxt; int ui = 0;
    if (!S.next(0, cur)) return;
    f32x4 acc[2][2][4][2];
#pragma unroll
    for (int a = 0; a < 2; ++a)
#pragma unroll
        for (int b = 0; b < 2; ++b)
#pragma unroll
            for (int m = 0; m < 4; ++m)
#pragma unroll
                for (int n = 0; n < 2; ++n) acc[a][b][m][n] = (f32x4){0.f, 0.f, 0.f, 0.f};
    bf16x8 At[4][2], B0[2][2], B1[2][2];
    const char* cA = PG8_UA(cur); const char* cB = PG8_UB(cur);
    PG8_STAGE(PG8_SB(0, 0), cB, voffB); PG8_STAGE(PG8_SB(0, 1), cB + hsB, voffB); PG8_STAGE(PG8_SA(0, 0), cA, voffA); PG8_STAGE(PG8_SA(0, 1), cA + hsA, voffA);
    if (wr == 1) PG8_BAR;
    PG8_WAIT_V(2); PG8_BAR;
    PG8_STAGE(PG8_SB(1, 0), cB + kstep, voffB); PG8_STAGE(PG8_SA(1, 0), cA + kstep, voffA); PG8_STAGE(PG8_SB(1, 1), cB + hsB + kstep, voffB);
    PG8_WAIT_V(6); PG8_BAR;
    for (;;) {
        const bool has_next = S.next(ui + 1, nxt);
        const char* nA = has_next ? PG8_UA(nxt) : cA; const char* nB = has_next ? PG8_UB(nxt) : cB;
        const int nt_first = Epi::MID ? (nt >> 1) : nt;
        for (int t = 0; t < nt_first; t += 2) {
            const bool last = (t == nt - 2);
            const char* a1 = cA + (size_t)(t + 1) * kstep;
            const char* a2 = last ? nA : cA + (size_t)(t + 2) * kstep; const char* b2 = last ? nB : cB + (size_t)(t + 2) * kstep;
            const char* a3 = a2 + kstep; const char* b3 = b2 + kstep;
            PG8_LDB(B0, 0, 0); PG8_LDB(B1, 0, 1); PG8_SCHED; PG8_LDA(At, 0, 0); PG8_STAGE(PG8_SA(1, 1), a1 + hsA, voffA);
            PG8_WAIT_V(8); PG8_WAIT_L(0); PG8_BAR; PG8_MMA(0, 0, At, B0); PG8_MMA(0, 1, At, B1); PG8_BAR; PG8_SCHED;
            PG8_LDA(At, 0, 1); PG8_STAGE(PG8_SB(0, 0), b2, voffB); PG8_STAGE(PG8_SB(0, 1), b2 + hsB, voffB); PG8_STAGE(PG8_SA(0, 0), a2, voffA);
            PG8_WAIT_V(8); PG8_WAIT_L(0); PG8_BAR; PG8_MMA(1, 0, At, B0); PG8_MMA(1, 1, At, B1); PG8_BAR; PG8_SCHED;
            PG8_LDB(B0, 1, 0); PG8_LDB(B1, 1, 1); PG8_SCHED; PG8_LDA(At, 1, 0); PG8_STAGE(PG8_SA(0, 1), a2 + hsA, voffA);
            PG8_WAIT_V(8); PG8_WAIT_L(0); PG8_BAR; PG8_MMA(0, 0, At, B0); PG8_MMA(0, 1, At, B1); PG8_BAR; PG8_SCHED;
            PG8_LDA(At, 1, 1); PG8_STAGE(PG8_SB(1, 0), b3, voffB); PG8_STAGE(PG8_SB(1, 1), b3 + hsB, voffB); PG8_STAGE(PG8_SA(1, 0), a3, voffA);
            PG8_WAIT_V(8); PG8_WAIT_L(0); PG8_BAR; PG8_MMA(1, 0, At, B0); PG8_MMA(1, 1, At, B1); PG8_BAR; PG8_SCHED;
        }
        if constexpr (Epi::MID) {
            E.mid(acc, cur, wr, wc, fr, fq);
            for (int t = nt_first; t < nt; t += 2) {
            const bool last = (t == nt - 2);
            const char* a1 = cA + (size_t)(t + 1) * kstep;
            const char* a2 = last ? nA : cA + (size_t)(t + 2) * kstep; const char* b2 = last ? nB : cB + (size_t)(t + 2) * kstep;
            const char* a3 = a2 + kstep; const char* b3 = b2 + kstep;
            PG8_LDB(B0, 0, 0); PG8_LDB(B1, 0, 1); PG8_SCHED; PG8_LDA(At, 0, 0); PG8_STAGE(PG8_SA(1, 1), a1 + hsA, voffA);
            PG8_WAIT_V(8); PG8_WAIT_L(0); PG8_BAR; PG8_MMA(0, 0, At, B0); PG8_MMA(0, 1, At, B1); PG8_BAR; PG8_SCHED;
            PG8_LDA(At, 0, 1); PG8_STAGE(PG8_SB(0, 0), b2, voffB); PG8_STAGE(PG8_SB(0, 1), b2 + hsB, voffB); PG8_STAGE(PG8_SA(0, 0), a2, voffA);
            PG8_WAIT_V(8); PG8_WAIT_L(0); PG8_BAR; PG8_MMA(1, 0, At, B0); PG8_MMA(1, 1, At, B1); PG8_BAR; PG8_SCHED;
            PG8_LDB(B0, 1, 0); PG8_LDB(B1, 1, 1); PG8_SCHED; PG8_LDA(At, 1, 0); PG8_STAGE(PG8_SA(0, 1), a2 + hsA, voffA);
            PG8_WAIT_V(8); PG8_WAIT_L(0); PG8_BAR; PG8_MMA(0, 0, At, B0); PG8_MMA(0, 1, At, B1); PG8_BAR; PG8_SCHED;
            PG8_LDA(At, 1, 1); PG8_STAGE(PG8_SB(1, 0), b3, voffB); PG8_STAGE(PG8_SB(1, 1), b3 + hsB, voffB); PG8_STAGE(PG8_SA(1, 0), a3, voffA);
            PG8_WAIT_V(8); PG8_WAIT_L(0); PG8_BAR; PG8_MMA(1, 0, At, B0); PG8_MMA(1, 1, At, B1); PG8_BAR; PG8_SCHED;
            }
        }
        if (wr == 0) PG8_BAR;
        E(acc, cur, wr, wc, fr, fq);
        if (!has_next) break;
#pragma unroll
        for (int a = 0; a < 2; ++a)
#pragma unroll
            for (int b = 0; b < 2; ++b)
#pragma unroll
                for (int m = 0; m < 4; ++m)
#pragma unroll
                    for (int n = 0; n < 2; ++n) acc[a][b][m][n] = (f32x4){0.f, 0.f, 0.f, 0.f};
        cur = nxt; cA = nA; cB = nB; ++ui;
        if (wr == 1) PG8_BAR;
    }
    PG8_WAIT_V(0);
    PG8_BAR;
#undef PG8_SA
#undef PG8_SB
#undef PG8_STAGE
#undef PG8_LDA
#undef PG8_LDB
#undef PG8_MMA
#undef PG8_WAIT_V
#undef PG8_WAIT_L
#undef PG8_BAR
#undef PG8_SCHED
#undef PG8_UA
#undef PG8_UB
}

#define EPI_ARGS const f32x4 (&acc)[2][2][4][2], const Unit& u, int wr, int wc, int fr, int fq
#define EPI_ROWS _Pragma("unroll") for (int ai = 0; ai < 2; ++ai) _Pragma("unroll") for (int m = 0; m < 4; ++m)
#define EPI_BJ _Pragma("unroll") for (int bj = 0; bj < 2; ++bj)
DI u32x4 pk8(const f32x4 a, const f32x4 b) { u32x4 r; r.x = pk2(a[0], a[1]); r.y = pk2(a[2], a[3]); r.z = pk2(b[0], b[1]); r.w = pk2(b[2], b[3]); return r; }
DI void unpk8(const u32x4 w, f32x4& a, f32x4& b) { a[0] = bf2f(w.x & 0xffffu); a[1] = bf2f(w.x >> 16); a[2] = bf2f(w.y & 0xffffu); a[3] = bf2f(w.y >> 16); b[0] = bf2f(w.z & 0xffffu); b[1] = bf2f(w.z >> 16); b[2] = bf2f(w.w & 0xffffu); b[3] = bf2f(w.w >> 16); }
DI f32x4 sig4(const f32x4 v) { f32x4 s; s[0] = sigmoidf_(v[0]); s[1] = sigmoidf_(v[1]); s[2] = sigmoidf_(v[2]); s[3] = sigmoidf_(v[3]); return s; }

struct EpiInProj {
    static constexpr bool MID = false;
    bf16_t *Ug, *Q, *Kb, *Vt, *SGs, *SGa; const float* rope;
    DI void operator()(EPI_ARGS) const {
        const int pn = u.pn; const int rbase = u.pm * 256 + wr * 64 + fr;
        EPI_ROWS {
            const int r = rbase + ai * 128 + m * 16;
            const bool lat = r < MLAT;
            int b, t; if (lat) { b = r >> 11; t = r & 2047; } else { const int rr = r - MLAT; b = rr >> 8; t = rr & 255; }
            if (pn < 4) {
                EPI_BJ { const int col = pn * 256 + bj * 128 + wc * 32 + fq * 8; const int g = col >> 4, cc = col & 15;
                    bf16_t* p = Ug + (size_t)g * (UROWS_PAD * UK) + (size_t)(r >> 5) * UK + (r & 31) * 16 + cc; *(u32x4*)p = pk8(acc[ai][bj][m][0], acc[ai][bj][m][1]); }
            } else if (pn < 12) {
                const bool isq = pn < 8;
                const int pos = (wc & 1) ? (t & 63) : (t >> 6);
                const f32x4* rp = (const f32x4*)(rope + (pos * 16 + (fq & 1) * 8) * 2);
                f32x4 cs[4];
#pragma unroll
                for (int e = 0; e < 4; ++e) cs[e] = (f32x4){1.f, 0.f, 1.f, 0.f};
                if (lat) {
#pragma unroll
                    for (int e = 0; e < 4; ++e) cs[e] = rp[e];
                }
                const float sgn = (fq & 2) ? 1.f : -1.f;
                bf16_t* dst = isq ? Q + (size_t)r * 1024 : Kb + (size_t)(b * KVLEN + (lat ? t : SEQ + t)) * 1024;
                EPI_BJ {
                    f32x4 o[2];
#pragma unroll
                    for (int n = 0; n < 2; ++n)
#pragma unroll
                        for (int i = 0; i < 4; ++i) { const float v = acc[ai][bj][m][n][i]; const float pv = __shfl_xor(v, 32); const int e = n * 4 + i;
                            const float cc = cs[e >> 1][(e & 1) * 2], ss = cs[e >> 1][(e & 1) * 2 + 1]; o[n][i] = v * cc + sgn * pv * ss; }
                    if (isq) { o[0] = o[0] * QSCALE; o[1] = o[1] * QSCALE; }
                    const int col0 = (pn - (isq ? 4 : 8)) * 256 + bj * 128 + wc * 32 + fq * 8;
                    *(u32x4*)(dst + col0) = pk8(o[0], o[1]);
                }
            } else if (pn < 16) {
                const int kvpos = lat ? t : SEQ + t;
                EPI_BJ { const int colv = (pn - 12) * 256 + bj * 128 + wc * 32 + fq * 8; bf16_t* p = Vt + (size_t)(b * 1024 + colv) * KVLEN + kvpos;
                    const f32x4 v0 = acc[ai][bj][m][0], v1 = acc[ai][bj][m][1];
                    p[0] = f2bf1(v0[0]); p[KVLEN] = f2bf1(v0[1]); p[2 * KVLEN] = f2bf1(v0[2]); p[3 * KVLEN] = f2bf1(v0[3]);
                    p[4 * KVLEN] = f2bf1(v1[0]); p[5 * KVLEN] = f2bf1(v1[1]); p[6 * KVLEN] = f2bf1(v1[2]); p[7 * KVLEN] = f2bf1(v1[3]); }
            } else {
                bf16_t* dst = (pn < 24 ? SGs : SGa) + (size_t)r * 2048 + (pn - (pn < 24 ? 16 : 24)) * 256;
                EPI_BJ { const int col = bj * 128 + wc * 32 + fq * 8; *(u32x4*)(dst + col) = pk8(sig4(acc[ai][bj][m][0]), sig4(acc[ai][bj][m][1])); }
            }
        }
    }
};
struct EpiSsm1 {
    static constexpr bool MID = false;
    float* S;
    DI void operator()(EPI_ARGS) const {
        EPI_ROWS { const int r = u.pm * 256 + wr * 64 + fr + ai * 128 + m * 16; float* rowp = S + ((size_t)u.bz * UROWS_PAD + r) * 256;
            EPI_BJ { const int col = bj * 128 + wc * 32 + fq * 8; *(f32x4*)(rowp + col) = acc[ai][bj][m][0]; *(f32x4*)(rowp + col + 4) = acc[ai][bj][m][1]; } }
    }
};
DI float gelu_tanh(float y) { const float a = 1.5957691216057308f * (y + 0.044715f * y * y * y); return y * sigmoidf_(a); }
DI f32x4 gelu4(const f32x4 v) { f32x4 z; z[0] = gelu_tanh(v[0]); z[1] = gelu_tanh(v[1]); z[2] = gelu_tanh(v[2]); z[3] = gelu_tanh(v[3]); return z; }
struct EpiSsm3 {
    static constexpr bool MID = false;
    bf16_t* Z;
    DI void operator()(EPI_ARGS) const {
        EPI_ROWS { const int r = u.pm * 256 + wr * 64 + fr + ai * 128 + m * 16;
            EPI_BJ { const int coln = u.pn * 256 + bj * 128 + wc * 32 + fq * 8; const int t = coln >> 4, c = coln & 15;
                *(u32x4*)(Z + (size_t)(r * TCH + t) * 1024 + u.bz * 16 + c) = pk8(gelu4(acc[ai][bj][m][0]), gelu4(acc[ai][bj][m][1])); } }
    }
};
struct EpiGlu {
    static constexpr bool MID = false;
    const bf16_t* Z; const float* bglu; bf16_t* Y;
    DI void operator()(EPI_ARGS) const {
        EPI_ROWS { const int r = u.pm * 256 + wr * 64 + fr + ai * 128 + m * 16;
            EPI_BJ { const int col = u.pn * 256 + bj * 128 + wc * 32 + fq * 8; const f32x4 b0 = *(const f32x4*)(bglu + col), b1 = *(const f32x4*)(bglu + col + 4);
                f32x4 z0, z1; unpk8(*(const u32x4*)(Z + (size_t)r * 1024 + col), z0, z1);
                *(u32x4*)(Y + (size_t)r * 2048 + col) = pk8(z0 * sig4(acc[ai][bj][m][0] + b0), z1 * sig4(acc[ai][bj][m][1] + b1)); } }
    }
};
struct EpiProj1 {
    static constexpr bool MID = false;
    const bf16_t* SG; bf16_t* tmp;
    DI void operator()(EPI_ARGS) const {
        EPI_ROWS { const int r = u.pm * 256 + wr * 64 + fr + ai * 128 + m * 16;
            EPI_BJ { const int col = u.pn * 256 + bj * 128 + wc * 32 + fq * 8; f32x4 s0, s1; unpk8(*(const u32x4*)(SG + (size_t)r * 2048 + col), s0, s1);
                *(u32x4*)(tmp + (size_t)r * 2048 + col) = pk8(s0 * acc[ai][bj][m][0], s1 * acc[ai][bj][m][1]); } }
    }
};
struct EpiProj2 {
    static constexpr bool MID = false;
    const bf16_t* SG; const bf16_t* tmp; bf16_t* Mg;
    DI void operator()(EPI_ARGS) const {
        EPI_ROWS { const int r = u.pm * 256 + wr * 64 + fr + ai * 128 + m * 16;
            EPI_BJ { const int col = u.pn * 256 + bj * 128 + wc * 32 + fq * 8; f32x4 s0, s1, t0, t1; unpk8(*(const u32x4*)(SG + (size_t)r * 2048 + col), s0, s1);
                unpk8(*(const u32x4*)(tmp + (size_t)r * 2048 + col), t0, t1);
                *(u32x4*)(Mg + (size_t)r * 2048 + col) = pk8(t0 + s0 * acc[ai][bj][m][0], t1 + s1 * acc[ai][bj][m][1]); } }
    }
};
struct EpiMerge {
    static constexpr bool MID = true;
    const bf16_t* SGs; const bf16_t* SGa; bf16_t* Mg;
    DI void mid(f32x4 (&acc)[2][2][4][2], const Unit& u, int wr, int wc, int fr, int fq) const {
        EPI_ROWS { const int r = u.pm * 256 + wr * 64 + fr + ai * 128 + m * 16;
            EPI_BJ { const int col = u.pn * 256 + bj * 128 + wc * 32 + fq * 8; f32x4 s0, s1, a0, a1; unpk8(*(const u32x4*)(SGs + (size_t)r * 2048 + col), s0, s1); unpk8(*(const u32x4*)(SGa + (size_t)r * 2048 + col), a0, a1);
#pragma unroll
                for (int i = 0; i < 4; ++i) { acc[ai][bj][m][0][i] *= s0[i] * __builtin_amdgcn_rcpf(fmaxf(a0[i], 1e-20f)); acc[ai][bj][m][1][i] *= s1[i] * __builtin_amdgcn_rcpf(fmaxf(a1[i], 1e-20f)); }
                asm volatile("" ::: "memory"); } }
    }
    DI void operator()(EPI_ARGS) const {
        EPI_ROWS { const int r = u.pm * 256 + wr * 64 + fr + ai * 128 + m * 16;
            EPI_BJ { const int col = u.pn * 256 + bj * 128 + wc * 32 + fq * 8; f32x4 a0, a1; unpk8(*(const u32x4*)(SGa + (size_t)r * 2048 + col), a0, a1);
                *(u32x4*)(Mg + (size_t)r * 2048 + col) = pk8(a0 * acc[ai][bj][m][0], a1 * acc[ai][bj][m][1]); } }
    }
};
struct EpiResid {
    static constexpr bool MID = false;
    const float* base; const float* gate; float* out;
    DI void operator()(EPI_ARGS) const {
        EPI_ROWS { const int r = u.pm * 256 + wr * 64 + fr + ai * 128 + m * 16; const float* gp = gate + (size_t)(r >> 11) * NMOD;
            EPI_BJ { const int col = u.pn * 256 + bj * 128 + wc * 32 + fq * 8; const f32x4 g0 = *(const f32x4*)(gp + col), g1 = *(const f32x4*)(gp + col + 4);
                const float* bp = base + (size_t)r * 2048 + col; const f32x4 b0 = *(const f32x4*)(bp), b1 = *(const f32x4*)(bp + 4);
                float* op = out + (size_t)r * 2048 + col; *(f32x4*)(op) = b0 + g0 * acc[ai][bj][m][0]; *(f32x4*)(op + 4) = b1 + g1 * acc[ai][bj][m][1]; } }
    }
};
struct EpiFfnIn {
    static constexpr bool MID = false;
    bf16_t* Hd;
    DI void operator()(EPI_ARGS) const {
        EPI_ROWS { const int r = u.pm * 256 + wr * 64 + fr + ai * 128 + m * 16;
            const int col = u.pn * 128 + wc * 32 + fq * 8;
            const f32x4 g0 = acc[ai][0][m][0], g1 = acc[ai][0][m][1];
            *(u32x4*)(Hd + (size_t)r * DFF + col) = pk8(g0 * sig4(g0) * acc[ai][1][m][0], g1 * sig4(g1) * acc[ai][1][m][1]); }
    }
};
}

namespace att {
constexpr int KROWB = 272, VROWB = 144, KT_BYTES = 64 * KROWB, VT_BYTES = 128 * VROWB, BUF = KT_BYTES + VT_BYTES, XCH_OFF = 2 * BUF;
#define MFMA32(a, b, c) __builtin_amdgcn_mfma_f32_32x32x16_bf16((a), (b), (c), 0, 0, 0)
DI void attn_phase(LAS unsigned char* lds, const bf16_t* Q, const bf16_t* Kb, const bf16_t* Vt, bf16_t* O, const float* subln, const float* lamp, int G, int cblk) {
    const int tid = threadIdx.x, lane = tid & 63, w = __builtin_amdgcn_readfirstlane(tid >> 6), q32 = lane & 31, hi = lane >> 5;
    const int map = w >> 2;
    const float lam = lamp[0];
    const int krow = (q32 & ~12) | ((q32 & 4) << 1) | ((q32 & 8) >> 1);
    const int kdst = (tid >> 4) * KROWB + (tid & 15) * 16;
    const int vdst = KT_BYTES + (tid >> 3) * VROWB + (tid & 7) * 16;
    const int kfo = krow * KROWB + (map * 64 + hi * 8) * 2;
    const int vfo = KT_BYTES + q32 * VROWB + hi * 16;
    const int vcu = (G % 8 == 0) ? (cblk % 8) * (G / 8) + cblk / 8 : cblk;
    for (int L = vcu; L < NB * 8 * 16; L += G) {
        const int bh = L >> 4, qb = L & 15, b = bh >> 3, h = bh & 7;
        const int qrow = b * SEQ + qb * 128 + (w & 3) * 32 + q32;
        bf16x8 qf[4];
        { const bf16_t* qp = Q + (size_t)qrow * 1024 + h * 128 + map * 64 + hi * 8;
#pragma unroll
          for (int ds = 0; ds < 4; ++ds) qf[ds] = *(const bf16x8*)(qp + ds * 16); }
        const bf16_t* ksrc = Kb + ((size_t)(b * KVLEN) + (tid >> 4)) * 1024 + h * 128 + (tid & 15) * 8;
        const bf16_t* vsrc = Vt + ((size_t)(bh * 128) + (tid >> 3)) * KVLEN + (tid & 7) * 8;
        u32x4 kr0, kr1, vr0, vr1;
        kr0 = *(const u32x4*)(ksrc); kr1 = *(const u32x4*)(ksrc + 32 * 1024); vr0 = *(const u32x4*)(vsrc); vr1 = *(const u32x4*)(vsrc + (size_t)64 * KVLEN);
        *(LAS u32x4*)(lds + kdst) = kr0; *(LAS u32x4*)(lds + kdst + 32 * KROWB) = kr1; *(LAS u32x4*)(lds + vdst) = vr0; *(LAS u32x4*)(lds + vdst + 64 * VROWB) = vr1;
        __syncthreads();
        f32x16 o[4];
#pragma unroll
        for (int db = 0; db < 4; ++db)
#pragma unroll
            for (int r = 0; r < 16; ++r) o[db][r] = 0.f;
        float mrun = -1e30f, lsum = 0.f;
        for (int t = 0; t < KVLEN / 64; ++t) {
            const bool more = (t + 1 < KVLEN / 64);
            if (more) { const bf16_t* kp = ksrc + (size_t)(t + 1) * 64 * 1024; const bf16_t* vp = vsrc + (t + 1) * 64;
                kr0 = *(const u32x4*)(kp); kr1 = *(const u32x4*)(kp + 32 * 1024); vr0 = *(const u32x4*)(vp); vr1 = *(const u32x4*)(vp + (size_t)64 * KVLEN); }
            LAS unsigned char* bufp = lds + (t & 1) * BUF;
            f32x16 st[2];
            bf16x8 kf[8];
#pragma unroll
            for (int i = 0; i < 8; ++i) kf[i] = *(const LAS bf16x8*)(bufp + kfo + (i >> 2) * 32 * KROWB + (i & 3) * 32);
            __builtin_amdgcn_sched_barrier(0);
#pragma unroll
            for (int r = 0; r < 16; ++r) { st[0][r] = 0.f; st[1][r] = 0.f; }
#pragma unroll
            for (int ds = 0; ds < 4; ++ds) { st[0] = MFMA32(kf[ds], qf[ds], st[0]); st[1] = MFMA32(kf[4 + ds], qf[ds], st[1]); }
            bf16x8 vf[16];
#pragma unroll
            for (int i = 0; i < 8; ++i) vf[i] = *(const LAS bf16x8*)(bufp + vfo + (i & 3) * 32 * VROWB + (i >> 2) * 32);
            __builtin_amdgcn_sched_barrier(0);
            float mx = st[0][0];
#pragma unroll
            for (int r = 1; r < 16; ++r) mx = fmaxf(mx, st[0][r]);
#pragma unroll
            for (int r = 0; r < 16; ++r) mx = fmaxf(mx, st[1][r]);
            mx = fmaxf(mx, __shfl_xor(mx, 32));
            if (__any(mx > mrun + 8.f)) {
                const float mn = fmaxf(mrun, mx); const float al = __builtin_amdgcn_exp2f(mrun - mn); lsum *= al; mrun = mn;
#pragma unroll
                for (int db = 0; db < 4; ++db)
#pragma unroll
                    for (int r = 0; r < 16; ++r) o[db][r] *= al;
            }
            float ps = 0.f;
#pragma unroll
            for (int kb = 0; kb < 2; ++kb)
#pragma unroll
                for (int r = 0; r < 16; ++r) { const float p = __builtin_amdgcn_exp2f(st[kb][r] - mrun); st[kb][r] = p; ps += p; }
            lsum += ps;
#pragma unroll
            for (int i = 8; i < 16; ++i) vf[i] = *(const LAS bf16x8*)(bufp + vfo + (i & 3) * 32 * VROWB + (i >> 2) * 32);
#pragma unroll
            for (int kb = 0; kb < 2; ++kb)
#pragma unroll
                for (int s = 0; s < 2; ++s) {
                    u32x4 pw; pw.x = pk2(st[kb][8 * s + 0], st[kb][8 * s + 1]); pw.y = pk2(st[kb][8 * s + 2], st[kb][8 * s + 3]); pw.z = pk2(st[kb][8 * s + 4], st[kb][8 * s + 5]); pw.w = pk2(st[kb][8 * s + 6], st[kb][8 * s + 7]);
                    const bf16x8 pb = __builtin_bit_cast(bf16x8, pw);
#pragma unroll
                    for (int db = 0; db < 4; ++db) o[db] = MFMA32(vf[(kb * 2 + s) * 4 + db], pb, o[db]);
                }
            if (more) { LAS unsigned char* nb = lds + ((t + 1) & 1) * BUF;
                *(LAS u32x4*)(nb + kdst) = kr0; *(LAS u32x4*)(nb + kdst + 32 * KROWB) = kr1; *(LAS u32x4*)(nb + vdst) = vr0; *(LAS u32x4*)(nb + vdst + 64 * VROWB) = vr1; }
            __syncthreads();
        }
        lsum += __shfl_xor(lsum, 32);
        const float inv = 1.f / lsum;
        LAS float* xp = (LAS float*)(lds + XCH_OFF) + ((w & 3) * 64) * 64 + lane;
        if (map == 1) {
#pragma unroll
            for (int db = 0; db < 4; ++db)
#pragma unroll
                for (int r = 0; r < 16; ++r) xp[(db * 16 + r) * 64] = o[db][r] * inv;
        }
        __syncthreads();
        if (map == 0) {
            float ss = 0.f;
#pragma unroll
            for (int db = 0; db < 4; ++db)
#pragma unroll
                for (int r = 0; r < 16; ++r) { const float v = o[db][r] * inv - lam * xp[(db * 16 + r) * 64]; o[db][r] = v; ss += v * v; }
            ss += __shfl_xor(ss, 32);
            const float rstd = rsqrtf(ss * (1.f / 128.f) + 1e-6f) * 0.8f;
            bf16_t* op = O + (size_t)qrow * 2048 + 1024 + h * 128;
#pragma unroll
            for (int db = 0; db < 4; ++db)
#pragma unroll
                for (int r4 = 0; r4 < 4; ++r4) { const int d0 = 32 * db + 8 * r4 + 4 * hi; const f32x4 gv = *(const f32x4*)(subln + d0); f32x4 v;
                    v[0] = o[db][4 * r4 + 0] * rstd * gv[0]; v[1] = o[db][4 * r4 + 1] * rstd * gv[1]; v[2] = o[db][4 * r4 + 2] * rstd * gv[2]; v[3] = o[db][4 * r4 + 3] * rstd * gv[3];
                    *(u32x2*)(op + d0) = pk4(v); }
        }
    }
}
}

struct Args { const float* in[30]; float* out; unsigned char* ws; int ph_lo, ph_hi, seg, pad; };

DI void transpose_item(const float* W, int K, int Nsrc, bf16_t* WT, int dest_n0, int src_n0, int k0, LAS float* scr, int lane) {
#pragma unroll 8
    for (int i = 0; i < 32; ++i) { const int kk = 2 * i + (lane >> 5); scr[kk * 33 + (lane & 31)] = W[(size_t)(k0 + kk) * Nsrc + src_n0 + (lane & 31)]; }
    asm volatile("s_waitcnt lgkmcnt(0)" ::: "memory");
    const int c = lane & 7;
#pragma unroll
    for (int j = 0; j < 4; ++j) { const int n = (lane >> 3) + 8 * j; const LAS float* s = scr + (8 * c) * 33 + n;
        u32x4 o; o.x = pk2(s[0 * 33], s[1 * 33]); o.y = pk2(s[2 * 33], s[3 * 33]); o.z = pk2(s[4 * 33], s[5 * 33]); o.w = pk2(s[6 * 33], s[7 * 33]);
        *(u32x4*)(WT + (size_t)(dest_n0 + n) * K + k0 + 8 * c) = o; }
    asm volatile("s_waitcnt lgkmcnt(0)" ::: "memory");
}

DI void mod_item(LAS unsigned char* lds, const float* cvec, const float* cctx, const float* wada, const float* bada, float* mod, int it) {
    const int tid = threadIdx.x, lane = tid & 63, w = tid >> 6;
    LAS float* sl = (LAS float*)lds + w * (17 * 256);
    for (int idx = lane; idx < 17 * 256; idx += 64) { const int r = idx >> 8, kk = idx & 255; const float cv = (r < 16) ? cvec[r * DM + 256 * w + kk] : cctx[256 * w + kk]; sl[idx] = cv * sigmoidf_(cv); }
    asm volatile("s_waitcnt lgkmcnt(0)" ::: "memory");
    const int col = it * 64 + lane;
    float acc[17];
#pragma unroll
    for (int r = 0; r < 17; ++r) acc[r] = 0.f;
    const float* wp = wada + (size_t)(256 * w) * NMOD + col;
    for (int kk = 0; kk < 256; kk += 8) {
        float wv[8];
#pragma unroll
        for (int e = 0; e < 8; ++e) wv[e] = wp[(size_t)(kk + e) * NMOD];
#pragma unroll
        for (int r = 0; r < 17; ++r) { const f32x4 s0 = *(const LAS f32x4*)(sl + r * 256 + kk), s1 = *(const LAS f32x4*)(sl + r * 256 + kk + 4);
            acc[r] += s0[0] * wv[0] + s0[1] * wv[1] + s0[2] * wv[2] + s0[3] * wv[3] + s1[0] * wv[4] + s1[1] * wv[5] + s1[2] * wv[6] + s1[3] * wv[7]; }
    }
    __syncthreads();
    LAS float* red = (LAS float*)lds;
#pragma unroll
    for (int r = 0; r < 17; ++r) red[(w * 17 + r) * 64 + lane] = acc[r];
    __syncthreads();
    for (int idx = tid; idx < 17 * 64; idx += NTHREADS) { const int r = idx >> 6, l = idx & 63; float s = bada[it * 64 + l];
#pragma unroll
        for (int ww = 0; ww < 8; ++ww) s += red[(ww * 17 + r) * 64 + l];
        mod[(size_t)r * NMOD + it * 64 + l] = s; }
    __syncthreads();
}

DI void transpose_tile64(const float* W, int K, int Nsrc, bf16_t* WT, int dest_n0, int src_n0, int k0, LAS float* scr, int lane) {
    f32x4 v[16];
    const float* src = W + (size_t)(k0 + (lane >> 4)) * Nsrc + src_n0 + (lane & 15) * 4;
#pragma unroll
    for (int i = 0; i < 16; ++i) v[i] = *(const f32x4*)(src + (size_t)(4 * i) * Nsrc);
#pragma unroll
    for (int i = 0; i < 16; ++i) { LAS float* p = scr + (4 * i + (lane >> 4)) * 65 + (lane & 15) * 4; p[0] = v[i][0]; p[1] = v[i][1]; p[2] = v[i][2]; p[3] = v[i][3]; }
    asm volatile("s_waitcnt lgkmcnt(0)" ::: "memory");
    const int c = lane & 7;
#pragma unroll
    for (int j = 0; j < 8; ++j) { const int n = (lane >> 3) + 8 * j; const LAS float* s = scr + (8 * c) * 65 + n;
        u32x4 o; o.x = pk2(s[0 * 65], s[1 * 65]); o.y = pk2(s[2 * 65], s[3 * 65]); o.z = pk2(s[4 * 65], s[5 * 65]); o.w = pk2(s[6 * 65], s[7 * 65]);
        *(u32x4*)(WT + (size_t)(dest_n0 + n) * K + k0 + 8 * c) = o; }
    asm volatile("s_waitcnt lgkmcnt(0)" ::: "memory");
}

DI void mod_item128(LAS unsigned char* lds, const float* cvec, const float* cctx, const float* wada, const float* bada, float* mod, int it) {
    const int tid = threadIdx.x, lane = tid & 63, w = tid >> 6;
    LAS float* sl = (LAS float*)lds + w * (17 * 256);
    for (int idx = lane; idx < 17 * 256; idx += 64) { const int r = idx >> 8, kk = idx & 255; const float cv = (r < 16) ? cvec[r * DM + 256 * w + kk] : cctx[256 * w + kk]; sl[idx] = cv * sigmoidf_(cv); }
    asm volatile("s_waitcnt lgkmcnt(0)" ::: "memory");
    const int col = it * 128 + 2 * lane;
    float a0[17], a1[17];
#pragma unroll
    for (int r = 0; r < 17; ++r) { a0[r] = 0.f; a1[r] = 0.f; }
    const float* wp = wada + (size_t)(256 * w) * NMOD + col;
    for (int kk = 0; kk < 256; kk += 32) {
        f32x2_t wv[32];
#pragma unroll
        for (int e = 0; e < 32; ++e) wv[e] = *(const f32x2_t*)(wp + (size_t)(kk + e) * NMOD);
#pragma unroll
        for (int r = 0; r < 17; ++r) {
#pragma unroll
            for (int q = 0; q < 8; ++q) { const f32x4 s4 = *(const LAS f32x4*)(sl + r * 256 + kk + 4 * q);
                a0[r] += s4[0] * wv[4 * q][0] + s4[1] * wv[4 * q + 1][0] + s4[2] * wv[4 * q + 2][0] + s4[3] * wv[4 * q + 3][0];
                a1[r] += s4[0] * wv[4 * q][1] + s4[1] * wv[4 * q + 1][1] + s4[2] * wv[4 * q + 2][1] + s4[3] * wv[4 * q + 3][1]; }
        }
    }
    __syncthreads();
    LAS float* red = (LAS float*)lds;
#pragma unroll
    for (int r = 0; r < 17; ++r) { red[(w * 17 + r) * 128 + 2 * lane] = a0[r]; red[(w * 17 + r) * 128 + 2 * lane + 1] = a1[r]; }
    __syncthreads();
    for (int idx = tid; idx < 17 * 128; idx += NTHREADS) { const int r = idx >> 7, c = idx & 127; float s = bada[it * 128 + c];
#pragma unroll
        for (int ww = 0; ww < 8; ++ww) s += red[(ww * 17 + r) * 128 + c];
        mod[(size_t)r * NMOD + it * 128 + c] = s; }
}

DI void ssm_coef_item(LAS unsigned char* lds, const float* const* in, bf16_t* Bt3, bf16_t* Bt1, float* lamT, int g) {
    const int tid = threadIdx.x;
    LAS float* Lam = (LAS float*)lds;
    LAS float* Bb = Lam + 2 * 33 * 64 * 2;
    LAS float* Cm = Bb + 2 * 64 * 16 * 2;
    LAS float* Km = Cm + 2 * 16 * 130;
    const float* a_re = in[8]; const float* a_im = in[9]; const float* log_dt = in[10]; const float* b_re = in[11]; const float* b_im = in[12];
    const float* c_re = in[13]; const float* c_im = in[14]; const float* dsk = in[15];
    if (tid < 128) {
        const int d = tid >> 6, p = tid & 63;
        const double dt = exp((double)log_dt[d * 64 + g]); const double lr = (double)a_re[(d * 64 + g) * 64 + p], li = (double)a_im[(d * 64 + g) * 64 + p];
        const double zr = lr * dt, zi = li * dt; const double mag = exp(zr); double rev = zi * 0.15915494309189535; rev -= floor(rev + 0.5); const double ang = rev * 6.283185307179586;
        const double er = mag * cos(ang), ei = mag * sin(ang);
        double pr = 1.0, pi = 0.0;
        for (int j = 0; j <= 32; ++j) { Lam[((d * 33 + j) * 64 + p) * 2] = (float)pr; Lam[((d * 33 + j) * 64 + p) * 2 + 1] = (float)pi; const double nr = pr * er - pi * ei, ni = pr * ei + pi * er; pr = nr; pi = ni; }
        const double den = lr * lr + li * li; const double e1 = er - 1.0; const double fr_ = (e1 * lr + ei * li) / den, fi_ = (ei * lr - e1 * li) / den;
        const float* brp = b_re + ((size_t)(d * 64 + g) * 64 + p) * 16; const float* bip = b_im + ((size_t)(d * 64 + g) * 64 + p) * 16;
#pragma unroll
        for (int c = 0; c < 16; ++c) { const double br = (double)brp[c], bi = (double)bip[c]; Bb[((d * 64 + p) * 16 + c) * 2] = (float)(fr_ * br - fi_ * bi); Bb[((d * 64 + p) * 16 + c) * 2 + 1] = (float)(fr_ * bi + fi_ * br); }
    }
    for (int idx = tid; idx < 2 * 16 * 64; idx += NTHREADS) { const int p = idx & 63, c = (idx >> 6) & 15, d = idx >> 10;
        Cm[(d * 16 + c) * 130 + p * 2] = c_re[((d * 64 + g) * 16 + c) * 64 + p]; Cm[(d * 16 + c) * 130 + p * 2 + 1] = c_im[((d * 64 + g) * 16 + c) * 64 + p]; }
    __syncthreads();
    {
        const int q4 = tid & 3, c = (tid >> 2) & 15, djl = tid >> 6;
        for (int rnd = 0; rnd < 8; ++rnd) {
            const int dj = rnd * 8 + djl, d = dj >> 5, j = dj & 31;
            float a0 = 0.f, a1 = 0.f, a2 = 0.f, a3 = 0.f;
            const LAS float* cmp = Cm + (d * 16 + c) * 130; const LAS float* lmp = Lam + ((d * 33 + j) * 64) * 2; const LAS float* bbp = Bb + (d * 64 * 16 + 4 * q4) * 2;
#pragma unroll 4
            for (int p = 0; p < 64; ++p) {
                const f32x2_t cv = *(const LAS f32x2_t*)(cmp + p * 2), lv = *(const LAS f32x2_t*)(lmp + p * 2);
                const f32x4 b01 = *(const LAS f32x4*)(bbp + p * 32), b23 = *(const LAS f32x4*)(bbp + p * 32 + 4);
                const float vr = cv[0] * lv[0] - cv[1] * lv[1], vi = cv[0] * lv[1] + cv[1] * lv[0];
                a0 += vr * b01[0] - vi * b01[1]; a1 += vr * b01[2] - vi * b01[3]; a2 += vr * b23[0] - vi * b23[1]; a3 += vr * b23[2] - vi * b23[3];
            }
            *(LAS f32x4*)(Km + ((d * 32 + j) * 16 + c) * 16 + 4 * q4) = (f32x4){a0, a1, a2, a3};
        }
    }
    __syncthreads();
    bf16_t* B3 = Bt3 + (size_t)g * 512 * UK;
    for (int idx = tid; idx < 512 * 96; idx += NTHREADS) {
        const int n = idx / 96, k0 = (idx % 96) * 8; const int t = n >> 4, c = n & 15;
        float v[8];
        if (k0 < 512) {
            const int s = k0 >> 4, c0 = k0 & 15;
#pragma unroll
            for (int e = 0; e < 8; ++e) { const int cp = c0 + e; float x;
                if (s < t) x = Km[((0 * 32 + (t - s)) * 16 + c) * 16 + cp];
                else if (s > t) x = Km[((1 * 32 + (s - t)) * 16 + c) * 16 + cp];
                else x = Km[(c) * 16 + cp] + Km[((32) * 16 + c) * 16 + cp] + (c == cp ? dsk[g * 16 + c] : 0.f);
                v[e] = x; }
        } else {
            const int kk = k0 - 512, sec = kk >> 6, p0 = kk & 63, d = sec >> 1, part = sec & 1; const int jj = d == 0 ? t + 1 : TCH - t;
#pragma unroll
            for (int e = 0; e < 8; ++e) { const int p = p0 + e;
                const float cr = Cm[(d * 16 + c) * 130 + p * 2], ci = Cm[(d * 16 + c) * 130 + p * 2 + 1];
                const float lr = Lam[((d * 33 + jj) * 64 + p) * 2], li = Lam[((d * 33 + jj) * 64 + p) * 2 + 1];
                v[e] = part == 0 ? (cr * lr - ci * li) : -(cr * li + ci * lr); }
        }
        u32x4 o; o.x = pk2(v[0], v[1]); o.y = pk2(v[2], v[3]); o.z = pk2(v[4], v[5]); o.w = pk2(v[6], v[7]);
        *(u32x4*)(B3 + (size_t)n * UK + k0) = o;
    }
    bf16_t* B1 = Bt1 + (size_t)g * 256 * 512;
    for (int idx = tid; idx < 256 * 64; idx += NTHREADS) {
        const int n = idx >> 6, k0 = (idx & 63) * 8; const int s = k0 >> 4, c0 = k0 & 15; const int d = n >> 7, part = (n >> 6) & 1, p = n & 63;
        const int ee = d == 0 ? (TCH - 1 - s) : s;
        const float lr = Lam[((d * 33 + ee) * 64 + p) * 2], li = Lam[((d * 33 + ee) * 64 + p) * 2 + 1];
        float v[8];
#pragma unroll
        for (int e = 0; e < 8; ++e) { const float br = Bb[((d * 64 + p) * 16 + c0 + e) * 2], bi = Bb[((d * 64 + p) * 16 + c0 + e) * 2 + 1]; v[e] = part == 0 ? (lr * br - li * bi) : (lr * bi + li * br); }
        u32x4 o; o.x = pk2(v[0], v[1]); o.y = pk2(v[2], v[3]); o.z = pk2(v[4], v[5]); o.w = pk2(v[6], v[7]);
        *(u32x4*)(B1 + (size_t)n * 512 + k0) = o;
    }
    for (int idx = tid; idx < 128; idx += NTHREADS) { const int d = idx >> 6, p = idx & 63; lamT[((g * 2 + d) * 64 + p) * 2] = Lam[((d * 33 + 32) * 64 + p) * 2]; lamT[((g * 2 + d) * 64 + p) * 2 + 1] = Lam[((d * 33 + 32) * 64 + p) * 2 + 1]; }
    __syncthreads();
}

DI void normmod_row(const float* xr, const float* gv, const float* sh, const float* sc, bf16_t* orow, int lane) {
    f32x4 v[8]; float ss = 0.f;
#pragma unroll
    for (int j = 0; j < 8; ++j) { v[j] = *(const f32x4*)(xr + 4 * lane + 256 * j); ss += (v[j][0] * v[j][0] + v[j][1] * v[j][1]) + (v[j][2] * v[j][2] + v[j][3] * v[j][3]); }
    const float rstd = rsqrtf(wave_sum(ss) * (1.f / DM) + 1e-6f);
#pragma unroll
    for (int j = 0; j < 8; ++j) { const int c = 4 * lane + 256 * j; const f32x4 g4 = *(const f32x4*)(gv + c), s4 = *(const f32x4*)(sh + c), c4 = *(const f32x4*)(sc + c);
        const f32x4 y = (v[j] * rstd * g4) * (c4 + 1.f) + s4; *(u32x2*)(orow + c) = pk4(y); }
}

constexpr int NPH = 14;
__global__ void __launch_bounds__(NTHREADS, 2) fwd_kernel(Args args) {
    extern __shared__ __attribute__((aligned(16))) unsigned char lds_raw[];
    LAS unsigned char* lds = (LAS unsigned char*)lds_raw;
    cg::grid_group grid = cg::this_grid();
    const int tid = threadIdx.x, lane = tid & 63, wave = __builtin_amdgcn_readfirstlane(tid >> 6);
    const int G = gridDim.x, cb = blockIdx.x;
    const int gw = cb * 8 + wave, NGW = G * 8;
    unsigned char* ws = args.ws;
    const float* x = args.in[0]; float* out = args.out;
#define Wt_in ((bf16_t*)(ws + WS_WIN))
#define Wt_glu ((bf16_t*)(ws + WS_WGLU))
#define Wt_ps ((bf16_t*)(ws + WS_WPS))
#define Wt_pa ((bf16_t*)(ws + WS_WPA))
#define Wt_out ((bf16_t*)(ws + WS_WOUT))
#define Wt_fi ((bf16_t*)(ws + WS_WFI))
#define Wt_fo ((bf16_t*)(ws + WS_WFO))
#define Bt3 ((bf16_t*)(ws + WS_BT3))
#define Bt1 ((bf16_t*)(ws + WS_BT1))
#define mod ((float*)(ws + WS_MOD))
#define rope ((float*)(ws + WS_ROPE))
#define lamS ((float*)(ws + WS_LAMS))
#define lamT ((float*)(ws + WS_LAMT))
#define Hb ((bf16_t*)(ws + WS_H))
#define Oatt ((bf16_t*)(ws + WS_OATT))
#define Yssm ((bf16_t*)(ws + WS_YSSM))
#define H2 ((bf16_t*)(ws + WS_H2))
#define Ug ((bf16_t*)(ws + WS_UG))
#define Sst ((float*)(ws + WS_S))
#define Vt ((bf16_t*)(ws + WS_VT))
#define tmp ((bf16_t*)(ws + WS_TMP))
#define Hid ((bf16_t*)(ws + WS_HID))
#define Qb ((bf16_t*)(ws + WS_Q))
#define Zb ((bf16_t*)(ws + WS_Z))
#define Kb ((bf16_t*)(ws + WS_K))
#define Mg ((bf16_t*)(ws + WS_MERGED))
#define SGs ((bf16_t*)(ws + WS_SGS))
#define SGa ((bf16_t*)(ws + WS_SGA))
    const int lo = args.ph_lo, hi_ph = args.ph_hi;
#define IN(k) (lo <= (k) && (k) < hi_ph)
#define SEAM(k) do { if (IN(k) && IN((k) + 1)) grid.sync(); } while (0)

    if (IN(0)) {
        if (cb == 0) {
            for (int idx = tid; idx < 64 * 16; idx += NTHREADS) { const int pos = idx >> 4, f = idx & 15; const float inv = powf(10000.f, -(float)f / 16.f); const float a = (float)pos * inv; rope[idx * 2] = cosf(a); rope[idx * 2 + 1] = sinf(a); }
            if (tid == 0) { float s1 = 0.f, s2 = 0.f; for (int i = 0; i < 64; ++i) { s1 += args.in[18][i] * args.in[19][i]; s2 += args.in[20][i] * args.in[21][i]; } lamS[0] = expf(s1) - expf(s2) + 0.2f; }
        }
        {
            constexpr int T0 = 32 * 128, T1 = 16 * 16, T2 = 16 * 32, T3 = 16 * 32, T4 = 32 * 32, T5 = 32 * 176, T6 = 88 * 32;
            constexpr int NITEMS = 64 + 96 + (T0 + T1 + T2 + T3 + T4 + T5 + T6) / 8;
            LAS int* qslot = (LAS int*)(lds + LDS_BYTES - 16);
            int* ctr = (int*)(ws + WS_CTR) + args.seg * 16;
            LAS float* scr = (LAS float*)(lds + wave * 16640);
            for (;;) {
                __syncthreads();
                if (tid == 0) *qslot = atomicAdd(ctr, 1);
                __syncthreads();
                const int it = *qslot;
                if (it >= NITEMS) break;
                if (it < 64) { if (args.pad & 1) ssm_coef_item(lds, args.in, Bt3, Bt1, lamT, it); }
                else if (it < 160) { if (args.pad & 2) mod_item128(lds, args.in[1], args.in[3], args.in[4], args.in[5], mod, it - 64); }
                else if (args.pad & 4) {
                    int r = (it - 160) * 8 + wave;
                    if (r < T0) { const int nblk = 128, kb = r / nblk, nb = r % nblk; transpose_tile64(args.in[7], DM, DIN, Wt_in, nb * 64, nb * 64, kb * 64, scr, lane); }
                    else if ((r -= T0) < T1) { const int nblk = 16, kb = r / nblk, nb = r % nblk; transpose_tile64(args.in[16], 1024, 1024, Wt_glu, nb * 64, nb * 64, kb * 64, scr, lane); }
                    else if ((r -= T1) < T2) { const int nblk = 32, kb = r / nblk, nb = r % nblk; transpose_tile64(args.in[23], 2048, DM, Wt_ps, nb * 64, nb * 64, kb * 64, scr, lane); }
                    else if ((r -= T2) < T3) { const int nblk = 32, kb = r / nblk, nb = r % nblk; transpose_tile64(args.in[24], 2048, DM, Wt_ps + 1024, nb * 64, nb * 64, kb * 64, scr, lane); }
                    else if ((r -= T3) < T4) { const int nblk = 32, kb = r / nblk, nb = r % nblk; transpose_tile64(args.in[25], DM, DM, Wt_out, nb * 64, nb * 64, kb * 64, scr, lane); }
                    else if ((r -= T4) < T5) { const int nblk = 176, kb = r / nblk, nb = r % nblk; const int n0 = nb * 64, tile = n0 >> 8, within = n0 & 255;
                        const int src = within < 128 ? tile * 128 + within : DFF + tile * 128 + (within - 128);
                        transpose_tile64(args.in[27], DM, 2 * DFF, Wt_fi, n0, src, kb * 64, scr, lane); }
                    else { r -= T5; const int nblk = 32, kb = r / nblk, nb = r % nblk; transpose_tile64(args.in[28], DFF, DM, Wt_fo, nb * 64, nb * 64, kb * 64, scr, lane); }
                }
            }
        }
    }
    SEAM(0);
    if (IN(1)) {
        for (int row = gw; row < MTOT; row += NGW) {
            const float* xr = row < MLAT ? x + (size_t)row * DM : args.in[2] + (size_t)(row - MLAT) * DM;
            const float* mr = mod + (size_t)(row < MLAT ? (row >> 11) : 16) * NMOD;
            normmod_row(xr, args.in[6], mr, mr + DM, Hb + (size_t)row * DM, lane);
        }
    }
    SEAM(1);
    if (IN(2)) {
        pg8::Gemm g{Hb, Wt_in, DM, DM, DM, 0, 0};
        pg8::EpiInProj E{Ug, Qb, Kb, Vt, SGs, SGa, rope};
        { pg8::StaticOrder S; S.init(MLAT / 256, DIN / 256, 1, G, cb); pg8::gemm_phase(lds, g, S, E); }
        { pg8::CtxOrder S{G, cb}; pg8::gemm_phase(lds, g, S, E); }
    }
    SEAM(2);
    if (IN(3)) {
        pg8::Gemm g{Ug, Bt1, UK, 512, 512, (size_t)UROWS_PAD * UK, (size_t)256 * 512};
        pg8::EpiSsm1 E{Sst};
        pg8::StaticOrder S; S.init(UROWS_PAD / 256, 1, 64, G, cb); pg8::gemm_phase(lds, g, S, E);
    }
    SEAM(3);
    if (IN(4)) {
        for (int idx = cb * NTHREADS + tid; idx < NB * 64 * 2 * 64; idx += G * NTHREADS) {
            const int p = idx & 63, d = (idx >> 6) & 1, g = (idx >> 7) & 63, b = idx >> 13;
            const float lr = lamT[((g * 2 + d) * 64 + p) * 2], li = lamT[((g * 2 + d) * 64 + p) * 2 + 1];
            const float* Sg = Sst + (size_t)g * UROWS_PAD * 256 + d * 128 + p;
            bf16_t* Up = Ug + (size_t)g * (UROWS_PAD * UK) + 512 + d * 128 + p;
            float hr = 0.f, hi = 0.f;
#pragma unroll
            for (int kk = 0; kk < 8; ++kk) { const int k = d ? 7 - kk : kk; const float* sp = Sg + (size_t)(1024 + b * 8 + k) * 256; const float sr = sp[0], si = sp[64];
                const float nr = lr * hr - li * hi + sr, ni = lr * hi + li * hr + si; hr = nr; hi = ni; }
#pragma unroll 8
            for (int kk = 0; kk < 64; ++kk) { const int k = d ? 63 - kk : kk; const int row = b * 64 + k; bf16_t* up = Up + (size_t)row * UK; up[0] = f2bf1(hr); up[64] = f2bf1(hi);
                const float* sp = Sg + (size_t)row * 256; const float sr = sp[0], si = sp[64];
                const float nr = lr * hr - li * hi + sr, ni = lr * hi + li * hr + si; hr = nr; hi = ni; }
        }
        att::attn_phase(lds, Qb, Kb, Vt, Oatt, args.in[22], lamS, G, cb);
    }
    SEAM(4);
    if (IN(5)) {
        pg8::Gemm g{Ug, Bt3, UK, UK, UK, (size_t)UROWS_PAD * UK, (size_t)512 * UK};
        pg8::EpiSsm3 E{Zb};
        pg8::StaticOrder S; S.init(4, 2, 64, G, cb); pg8::gemm_phase(lds, g, S, E);
    }
    SEAM(5);
    if (IN(6)) {
        pg8::Gemm g{Zb, Wt_glu, 1024, 1024, 1024, 0, 0};
        pg8::EpiGlu E{Zb, args.in[17], Oatt};
        pg8::StaticOrder S; S.init(MLAT / 256, 4, 1, G, cb); pg8::gemm_phase(lds, g, S, E);
    }
    SEAM(6);
    if (IN(7)) {
        pg8::Gemm g{Oatt, Wt_ps, DM, DM, DM, 0, 0};
        pg8::EpiMerge E{SGs, SGa, Mg};
        pg8::StaticOrder S; S.init(MLAT / 256, 8, 1, G, cb); pg8::gemm_phase(lds, g, S, E);
    }
    SEAM(7);
    if (IN(9)) {
        pg8::Gemm g{Mg, Wt_out, DM, DM, DM, 0, 0};
        pg8::EpiResid E{x, mod + 2 * DM, out};
        pg8::StaticOrder S; S.init(MLAT / 256, 8, 1, G, cb); pg8::gemm_phase(lds, g, S, E);
    }
    SEAM(9);
    if (IN(10)) {
        int ln = threadIdx.x & 63; asm volatile("" : "+v"(ln));
        for (int row = gw; row < MLAT; row += NGW) { const float* mr = mod + (size_t)(row >> 11) * NMOD; normmod_row(out + (size_t)row * DM, args.in[26], mr + 3 * DM, mr + 4 * DM, H2 + (size_t)row * DM, ln); }
    }
    SEAM(10);
    if (IN(11)) {
        pg8::Gemm g{H2, Wt_fi, DM, DM, DM, 0, 0};
        pg8::EpiFfnIn E{Hid};
        pg8::StaticOrder S; S.init(MLAT / 256, 44, 1, G, cb); pg8::gemm_phase(lds, g, S, E);
    }
    SEAM(11);
    if (IN(12)) {
        pg8::Gemm g{Hid, Wt_fo, DFF, DFF, DFF, 0, 0};
        pg8::EpiResid E{out, mod + 5 * DM, out};
        pg8::StaticOrder S; S.init(MLAT / 256, 8, 1, G, cb); pg8::gemm_phase(lds, g, S, E);
    }
    SEAM(12);
    if (IN(13)) {
        const float* gf = args.in[29]; int ln = threadIdx.x & 63; asm volatile("" : "+v"(ln));
        for (int row = gw; row < MLAT; row += NGW) {
            float* xr = out + (size_t)row * DM; f32x4 v[8]; float ss = 0.f;
#pragma unroll
            for (int j = 0; j < 8; ++j) { v[j] = *(const f32x4*)(xr + 4 * ln + 256 * j); ss += (v[j][0] * v[j][0] + v[j][1] * v[j][1]) + (v[j][2] * v[j][2] + v[j][3] * v[j][3]); }
            const float rstd = rsqrtf(wave_sum(ss) * (1.f / DM) + 1e-6f);
#pragma unroll
            for (int j = 0; j < 8; ++j) { const int c = 4 * ln + 256 * j; const f32x4 g4 = *(const f32x4*)(gf + c); *(f32x4*)(xr + c) = v[j] * rstd * g4; }
        }
    }
#undef IN
#undef SEAM
#undef Wt_in
#undef Wt_glu
#undef Wt_ps
#undef Wt_pa
#undef Wt_out
#undef Wt_fi
#undef Wt_fo
#undef Bt3
#undef Bt1
#undef mod
#undef rope
#undef lamS
#undef lamT
#undef Hb
#undef Oatt
#undef Yssm
#undef H2
#undef Ug
#undef Sst
#undef Vt
#undef tmp
#undef Hid
#undef Qb
#undef Zb
#undef Kb
#undef Mg
#undef SGs
#undef SGa
}

#ifndef SEGMENTS
#define SEGMENTS 0, 14, 7, -1
#endif
extern "C" void kernel_launch(void* const* d_in, const int* in_sizes, int n_in, void* d_out, int out_size, void* d_ws, size_t ws_size, hipStream_t stream) {
    static int grid = 0;
    if (grid == 0) {
        if (n_in != 30 || out_size != MLAT * DM || ws_size < WS_END) { fprintf(stderr, "kernel_launch: unexpected shapes (n_in %d out %d ws %zu)\n", n_in, out_size, ws_size); grid = -1; return; }
        int dev = 0, cus = 0, per_cu = 0;
        (void)hipGetDevice(&dev);
        (void)hipDeviceGetAttribute(&cus, hipDeviceAttributeMultiprocessorCount, dev);
        if (hipFuncSetAttribute((const void*)fwd_kernel, hipFuncAttributeMaxDynamicSharedMemorySize, LDS_BYTES) != hipSuccess) { fprintf(stderr, "kernel_launch: hipFuncSetAttribute failed\n"); grid = -1; return; }
        if (hipOccupancyMaxActiveBlocksPerMultiprocessor(&per_cu, (const void*)fwd_kernel, NTHREADS, LDS_BYTES) != hipSuccess || per_cu < 1) { fprintf(stderr, "kernel_launch: occupancy query says %d\n", per_cu); per_cu = 1; }
        (void)hipGetLastError();
        grid = cus * per_cu;
        fprintf(stderr, "kernel_launch: grid %d (cus %d x %d)\n", grid, cus, per_cu);
    }
    if (grid < 0) return;
    Args a{};
    for (int i = 0; i < 30; ++i) a.in[i] = (const float*)d_in[i];
    a.out = (float*)d_out; a.ws = (unsigned char*)d_ws;
    (void)hipMemsetAsync((unsigned char*)d_ws + WS_CTR, 0, 256, stream);
    const int segs[] = {SEGMENTS};
    for (int si = 0; si + 2 < (int)(sizeof(segs) / sizeof(int)); si += 3) {
        a.ph_lo = segs[si]; a.ph_hi = segs[si + 1]; a.seg = si / 3; a.pad = segs[si + 2];
        void* kargs[] = {&a};
        hipError_t e = hipLaunchCooperativeKernel((const void*)fwd_kernel, dim3(grid), dim3(NTHREADS), kargs, LDS_BYTES, stream);
        if (e != hipSuccess) fprintf(stderr, "kernel_launch: cooperative launch failed: %s (grid %d)\n", hipGetErrorString(e), grid);
    }
}
```

```cpp
#include <hip/hip_runtime.h>
#include <hip/hip_cooperative_groups.h>
#include <cstdio>
#include <cstdint>
namespace cg = cooperative_groups;

#define LAS __attribute__((address_space(3)))
#define DI __device__ __forceinline__
typedef unsigned short bf16_t;
typedef short bf16x8 __attribute__((ext_vector_type(8)));
typedef float f32x4 __attribute__((ext_vector_type(4)));
typedef float f32x16 __attribute__((ext_vector_type(16)));
typedef unsigned u32x4 __attribute__((ext_vector_type(4)));
typedef unsigned u32x2 __attribute__((ext_vector_type(2)));
typedef float f32x2_t __attribute__((ext_vector_type(2)));
typedef __bf16 bf16x2_t __attribute__((ext_vector_type(2)));

constexpr int DM = 2048, NB = 16, SEQ = 2048, LCTX = 256, MLAT = NB * SEQ, MCTX = NB * LCTX, MTOT = MLAT + MCTX;
constexpr int KVLEN = SEQ + LCTX;
constexpr int DFF = 5632, DIN = 8192, NMOD = 6 * DM;
constexpr int TCH = 32;
constexpr int UROWS_PAD = 1280, UK = 768;
constexpr float QSCALE = 0.125f * 1.4426950408889634f;
constexpr int NTHREADS = 512;
constexpr int LDS_BYTES = 147456;

constexpr size_t MiB = 1u << 20;
constexpr size_t WS_WIN = 0, WS_WGLU = 32 * MiB, WS_WPS = 34 * MiB, WS_WPA = 38 * MiB, WS_WOUT = 42 * MiB, WS_WFI = 50 * MiB, WS_WFO = 94 * MiB;
constexpr size_t WS_BT3 = 116 * MiB, WS_BT1 = 164 * MiB, WS_MOD = 180 * MiB, WS_ROPE = 181 * MiB, WS_LAMS = 181 * MiB + 16384, WS_LAMT = 181 * MiB + 32768, WS_CTR = 181 * MiB + 131072, WS_BAR = 181 * MiB + 131072 + 1024, CTL_ZERO_BYTES = 1024 + 4 * 3456 * 4;
constexpr size_t WS_H = 182 * MiB, WS_OATT = 182 * MiB, WS_YSSM = 246 * MiB, WS_H2 = 182 * MiB;
constexpr size_t WS_UG = 326 * MiB, WS_S = 446 * MiB, WS_VT = 526 * MiB, WS_TMP = 326 * MiB, WS_HID = 326 * MiB;
constexpr size_t WS_Q = 598 * MiB, WS_Z = 598 * MiB, WS_K = 662 * MiB, WS_MERGED = 598 * MiB;
constexpr size_t WS_SGS = 734 * MiB, WS_SGA = 862 * MiB, WS_END = 990 * MiB;

DI unsigned pk2(float lo, float hi) { f32x2_t v = {lo, hi}; bf16x2_t b = __builtin_convertvector(v, bf16x2_t); return __builtin_bit_cast(unsigned, b); }
DI u32x2 pk4(f32x4 v) { u32x2 r; r.x = pk2(v[0], v[1]); r.y = pk2(v[2], v[3]); return r; }
DI float bf2f(unsigned h) { return __uint_as_float(h << 16); }
DI f32x4 unpk4(u32x2 w) { f32x4 r; r[0] = bf2f(w.x & 0xffffu); r[1] = bf2f(w.x >> 16); r[2] = bf2f(w.y & 0xffffu); r[3] = bf2f(w.y >> 16); return r; }
DI bf16_t f2bf1(float f) { return (bf16_t)(pk2(f, 0.f) & 0xffffu); }
DI float sigmoidf_(float x) { return __builtin_amdgcn_rcpf(1.f + __expf(-x)); }
DI float wave_sum(float v) {
#pragma unroll
    for (int o = 1; o < 64; o <<= 1) v += __shfl_xor(v, o);
    return v;
}

namespace pg8 {
constexpr int BM = 256, BK = 64, HALF = 128, HTB = HALF * BK * 2, STAGE_BYTES = 8 * HTB, NXCD = 8, WGM = 8;
__host__ __device__ __forceinline__ int lds_byte(int r, int c) { const int st = (r >> 4) * 2 + (c >> 5), rr = r & 15, cc = c & 31, ob = rr * 64 + cc * 2; return st * 1024 + (ob ^ (((ob >> 9) & 1) << 5)); }
__host__ __device__ __forceinline__ int perm32(int rho) { const int n = rho >> 4, i = rho & 15; return 8 * (i >> 2) + 4 * n + (i & 3); }
__host__ __device__ __forceinline__ void stage_rc(int b, int& R, int& C) { const int st = b / 1024, sb = b % 1024, swz = sb ^ (((sb >> 9) & 1) << 5); R = (st >> 1) * 16 + swz / 64; C = (st & 1) * 32 + (swz % 64) / 2; }

struct Unit { int pm, pn, bz; };
struct Gemm { const bf16_t* A; const bf16_t* Bt; int lda, ldb, K; size_t sA, sB; };

struct StaticOrder {
    int nM, nN, nB, nwg, G, c;
    DI void init(int nM_, int nN_, int nB_, int G_, int c_) { nM = nM_; nN = nN_; nB = nB_; nwg = nM_ * nN_; G = G_; c = c_; }
    DI bool next(int i, Unit& u) const {
        const int tot = nwg * nB; const long L = (long)i * G + c; if (L >= tot) return false;
        int wg = (int)L; { const int q = tot / NXCD, r = tot % NXCD, xcd = wg % NXCD, off = wg / NXCD; wg = (xcd < r ? xcd * (q + 1) : r * (q + 1) + (xcd - r) * q) + off; }
        u.bz = wg / nwg; const int wgid = wg % nwg;
        const int nig = WGM * nN, gid = wgid / nig, fm = gid * WGM, gsz = (nM - fm) < WGM ? (nM - fm) : WGM;
        u.pm = fm + ((wgid % nig) % gsz); u.pn = (wgid % nig) / gsz; return true;
    }
};
struct CtxOrder {
    int G, c;
    DI bool next(int i, Unit& u) const {
        const int L = i * G + c; if (L >= 16 * 12) return false;
        u.bz = 0; u.pm = 128 + L / 12; const int j = L % 12; u.pn = j < 4 ? j : j + 4; return true;
    }
};

template <class Epi, class Sched>
DI void gemm_phase(LAS unsigned char* lds, const Gemm g, const Sched& S, const Epi& E) {
    const int tid = threadIdx.x, wid = __builtin_amdgcn_readfirstlane(tid >> 6), lane = tid & 63, wr = wid >> 2, wc = wid & 3, fr = lane & 15, fq = lane >> 4;
    const int K = g.K, nt = K / BK;
    unsigned voffA[2], voffB[2];
#pragma unroll
    for (int i = 0; i < 2; ++i) { int R, C; stage_rc(tid * 16 + i * 8192, R, C); const int Rb = (R & ~31) + perm32(R & 31); voffA[i] = (unsigned)(R * g.lda + C) * 2u; voffB[i] = (unsigned)(Rb * g.ldb + C) * 2u; }
    const size_t kstep = (size_t)(BK * 2);
    const size_t hsA = (size_t)HALF * g.lda * 2, hsB = (size_t)HALF * g.ldb * 2;
    const unsigned ldsw = (unsigned)wid * 1024u;
    const int aoff = lds_byte(wr * 64 + fr, fq * 8), boff = lds_byte(wc * 32 + fr, fq * 8);
#define PG8_SA(b, h) (((b) * 2 + (h)) * HTB)
#define PG8_SB(b, h) ((4 + (b) * 2 + (h)) * HTB)
#define PG8_STAGE(bufoff, gbase, voff) do { _Pragma("unroll") for (int _i = 0; _i < 2; ++_i) \
        __builtin_amdgcn_global_load_lds((const unsigned*)((const char*)(gbase) + (voff)[_i]), (LAS unsigned*)(lds + (bufoff) + ldsw + _i * 8192), 16, 0, 0); } while (0)
#define PG8_LDA(dst, b, h) do { _Pragma("unroll") for (int m = 0; m < 4; ++m) _Pragma("unroll") for (int k = 0; k < 2; ++k) dst[m][k] = *(const LAS bf16x8*)(lds + PG8_SA(b, h) + aoff + m * 2048 + k * 1024); } while (0)
#define PG8_LDB(dst, b, h) do { _Pragma("unroll") for (int n = 0; n < 2; ++n) _Pragma("unroll") for (int k = 0; k < 2; ++k) dst[n][k] = *(const LAS bf16x8*)(lds + PG8_SB(b, h) + boff + n * 2048 + k * 1024); } while (0)
#define PG8_MMA(ai, bj, At, Bt) do { __builtin_amdgcn_s_setprio(1); _Pragma("unroll") for (int m = 0; m < 4; ++m) _Pragma("unroll") for (int n = 0; n < 2; ++n) _Pragma("unroll") for (int k = 0; k < 2; ++k) \
        acc[ai][bj][m][n] = __builtin_amdgcn_mfma_f32_16x16x32_bf16(Bt[n][k], At[m][k], acc[ai][bj][m][n], 0, 0, 0); __builtin_amdgcn_s_setprio(0); } while (0)
#define PG8_WAIT_V(n) asm volatile("s_waitcnt vmcnt(" #n ")" ::: "memory")
#define PG8_WAIT_L(n) asm volatile("s_waitcnt lgkmcnt(" #n ")" ::: "memory")
#define PG8_BAR __builtin_amdgcn_s_barrier()
#define PG8_SCHED __builtin_amdgcn_sched_barrier(0)
#define PG8_UA(u) ((const char*)g.A + ((size_t)(u).bz * g.sA + (size_t)(u).pm * BM * g.lda) * 2)
#define PG8_UB(u) ((const char*)g.Bt + ((size_t)(u).bz * g.sB + (size_t)(u).pn * BM * g.ldb) * 2)
    Unit cur, nxt; int ui = 0;
    if (!S.next(0, cur)) return;
    f32x4 acc[2][2][4][2];
#pragma unroll
    for (int a = 0; a < 2; ++a)
#pragma unroll
        for (int b = 0; b < 2; ++b)
#pragma unroll
            for (int m = 0; m < 4; ++m)
#pragma unroll
                for (int n = 0; n < 2; ++n) acc[a][b][m][n] = (f32x4){0.f, 0.f, 0.f, 0.f};
    bf16x8 At[4][2], B0[2][2], B1[2][2];
    const char* cA = PG8_UA(cur); const char* cB = PG8_UB(cur);
    PG8_STAGE(PG8_SB(0, 0), cB, voffB); PG8_STAGE(PG8_SB(0, 1), cB + hsB, voffB); PG8_STAGE(PG8_SA(0, 0), cA, voffA); PG8_STAGE(PG8_SA(0, 1), cA + hsA, voffA);
    if (wr == 1) PG8_BAR;
    PG8_WAIT_V(2); PG8_BAR;
    PG8_STAGE(PG8_SB(1, 0), cB + kstep, voffB); PG8_STAGE(PG8_SA(1, 0), cA + kstep, voffA); PG8_STAGE(PG8_SB(1, 1), cB + hsB + kstep, voffB);
    PG8_WAIT_V(6); PG8_BAR;
    for (;;) {
        const bool has_next = S.next(ui + 1, nxt);
        const char* nA = has_next ? PG8_UA(nxt) : cA; const char* nB = has_next ? PG8_UB(nxt) : cB;
        const int nt_first = Epi::MID ? (nt >> 1) : nt;
        for (int t = 0; t < nt_first; t += 2) {
            const bool last = (t == nt - 2);
            const char* a1 = cA + (size_t)(t + 1) * kstep;
            const char* a2 = last ? nA : cA + (size_t)(t + 2) * kstep; const char* b2 = last ? nB : cB + (size_t)(t + 2) * kstep;
            const char* a3 = a2 + kstep; const char* b3 = b2 + kstep;
            PG8_LDB(B0, 0, 0); PG8_LDB(B1, 0, 1); PG8_SCHED; PG8_LDA(At, 0, 0); PG8_STAGE(PG8_SA(1, 1), a1 + hsA, voffA);
            PG8_WAIT_V(8); PG8_WAIT_L(0); PG8_BAR; PG8_MMA(0, 0, At, B0); PG8_MMA(0, 1, At, B1); PG8_BAR; PG8_SCHED;
            PG8_LDA(At, 0, 1); PG8_STAGE(PG8_SB(0, 0), b2, voffB); PG8_STAGE(PG8_SB(0, 1), b2 + hsB, voffB); PG8_STAGE(PG8_SA(0, 0), a2, voffA);
            PG8_WAIT_V(8); PG8_WAIT_L(0); PG8_BAR; PG8_MMA(1, 0, At, B0); PG8_MMA(1, 1, At, B1); PG8_BAR; PG8_SCHED;
            PG8_LDB(B0, 1, 0); PG8_LDB(B1, 1, 1); PG8_SCHED; PG8_LDA(At, 1, 0); PG8_STAGE(PG8_SA(0, 1), a2 + hsA, voffA);
            PG8_WAIT_V(8); PG8_WAIT_L(0); PG8_BAR; PG8_MMA(0, 0, At, B0); PG8_MMA(0, 1, At, B1); PG8_BAR; PG8_SCHED;
            PG8_LDA(At, 1, 1); PG8_STAGE(PG8_SB(1, 0), b3, voffB); PG8_STAGE(PG8_SB(1, 1), b3 + hsB, voffB); PG8_STAGE(PG8_SA(1, 0), a3, voffA);
            PG8_WAIT_V(8); PG8_WAIT_L(0); PG8_BAR; PG8_MMA(1, 0, At, B0); PG8_MMA(1, 1, At, B1); PG8_BAR; PG8_SCHED;
        }
        if constexpr (Epi::MID) {
            E.mid(acc, cur, wr, wc, fr, fq);
            for (int t = nt_first; t < nt; t += 2) {
            const bool last = (t == nt - 2);
            const char* a1 = cA + (size_t)(t + 1) * kstep;
            const char* a2 = last ? nA : cA + (size_t)(t + 2) * kstep; const char* b2 = last ? nB : cB + (size_t)(t + 2) * kstep;
            const char* a3 = a2 + kstep; const char* b3 = b2 + kstep;
            PG8_LDB(B0, 0, 0); PG8_LDB(B1, 0, 1); PG8_SCHED; PG8_LDA(At, 0, 0); PG8_STAGE(PG8_SA(1, 1), a1 + hsA, voffA);
            PG8_WAIT_V(8); PG8_WAIT_L(0); PG8_BAR; PG8_MMA(0, 0, At, B0); PG8_MMA(0, 1, At, B1); PG8_BAR; PG8_SCHED;
            PG8_LDA(At, 0, 1); PG8_STAGE(PG8_SB(0, 0), b2, voffB); PG8_STAGE(PG8_SB(0, 1), b2 + hsB, voffB); PG8_STAGE(PG8_SA(0, 0), a2, voffA);
            PG8_WAIT_V(8); PG8_WAIT_L(0); PG8_BAR; PG8_MMA(1, 0, At, B0); PG8_MMA(1, 1, At, B1); PG8_BAR; PG8_SCHED;
            PG8_LDB(B0, 1, 0); PG8_LDB(B1, 1, 1); PG8_SCHED; PG8_LDA(At, 1, 0); PG8_STAGE(PG8_SA(0, 1), a2 + hsA, voffA);
            PG8_WAIT_V(8); PG8_WAIT_L(0); PG8_BAR; PG8_MMA(0, 0, At, B0); PG8_MMA(0, 1, At, B1); PG8_BAR; PG8_SCHED;
            PG8_LDA(At, 1, 1); PG8_STAGE(PG8_SB(1, 0), b3, voffB); PG8_STAGE(PG8_SB(1, 1), b3 + hsB, voffB); PG8_STAGE(PG8_SA(1, 0), a3, voffA);
            PG8_WAIT_V(8); PG8_WAIT_L(0); PG8_BAR; PG8_MMA(1, 0, At, B0); PG8_MMA(1, 1, At, B1); PG8_BAR; PG8_SCHED;
            }
        }
        if (wr == 0) PG8_BAR;
        E(acc, cur, wr, wc, fr, fq);
        if (!has_next) break;
#pragma unroll
        for (int a = 0; a < 2; ++a)
#pragma unroll
            for (int b = 0; b < 2; ++b)
#pragma unroll
                for (int m = 0; m < 4; ++m)
#pragma unroll
                    for (int n = 0; n < 2; ++n) acc[a][b][m][n] = (f32x4){0.f, 0.f, 0.f, 0.f};
        cur = nxt; cA = nA; cB = nB; ++ui;
        if (wr == 1) PG8_BAR;
    }
    PG8_WAIT_V(0);
    PG8_BAR;
#undef PG8_SA
#undef PG8_SB
#undef PG8_STAGE
#undef PG8_LDA
#undef PG8_LDB
#undef PG8_MMA
#undef PG8_WAIT_V
#undef PG8_WAIT_L
#undef PG8_BAR
#undef PG8_SCHED
#undef PG8_UA
#undef PG8_UB
}

#define EPI_ARGS const f32x4 (&acc)[2][2][4][2], const Unit& u, int wr, int wc, int fr, int fq
#define EPI_ROWS _Pragma("unroll") for (int ai = 0; ai < 2; ++ai) _Pragma("unroll") for (int m = 0; m < 4; ++m)
#define EPI_BJ _Pragma("unroll") for (int bj = 0; bj < 2; ++bj)
DI u32x4 pk8(const f32x4 a, const f32x4 b) { u32x4 r; r.x = pk2(a[0], a[1]); r.y = pk2(a[2], a[3]); r.z = pk2(b[0], b[1]); r.w = pk2(b[2], b[3]); return r; }
DI void unpk8(const u32x4 w, f32x4& a, f32x4& b) { a[0] = bf2f(w.x & 0xffffu); a[1] = bf2f(w.x >> 16); a[2] = bf2f(w.y & 0xffffu); a[3] = bf2f(w.y >> 16); b[0] = bf2f(w.z & 0xffffu); b[1] = bf2f(w.z >> 16); b[2] = bf2f(w.w & 0xffffu); b[3] = bf2f(w.w >> 16); }
DI f32x4 sig4(const f32x4 v) { f32x4 s; s[0] = sigmoidf_(v[0]); s[1] = sigmoidf_(v[1]); s[2] = sigmoidf_(v[2]); s[3] = sigmoidf_(v[3]); return s; }

struct EpiInProj {
    static constexpr bool MID = false;
    bf16_t *Ug, *Q, *Kb, *Vt, *SGs, *SGa; const float* rope;
    DI void operator()(EPI_ARGS) const {
        const int pn = u.pn; const int rbase = u.pm * 256 + wr * 64 + fr;
        EPI_ROWS {
            const int r = rbase + ai * 128 + m * 16;
            const bool lat = r < MLAT;
            int b, t; if (lat) { b = r >> 11; t = r & 2047; } else { const int rr = r - MLAT; b = rr >> 8; t = rr & 255; }
            if (pn < 4) {
                EPI_BJ { const int col = pn * 256 + bj * 128 + wc * 32 + fq * 8; const int g = col >> 4, cc = col & 15;
                    bf16_t* p = Ug + (size_t)g * (UROWS_PAD * UK) + (size_t)(r >> 5) * UK + (r & 31) * 16 + cc; *(u32x4*)p = pk8(acc[ai][bj][m][0], acc[ai][bj][m][1]); }
            } else if (pn < 12) {
                const bool isq = pn < 8;
                const int pos = (wc & 1) ? (t & 63) : (t >> 6);
                const f32x4* rp = (const f32x4*)(rope + (pos * 16 + (fq & 1) * 8) * 2);
                f32x4 cs[4];
#pragma unroll
                for (int e = 0; e < 4; ++e) cs[e] = (f32x4){1.f, 0.f, 1.f, 0.f};
                if (lat) {
#pragma unroll
                    for (int e = 0; e < 4; ++e) cs[e] = rp[e];
                }
                const float sgn = (fq & 2) ? 1.f : -1.f;
                bf16_t* dst = isq ? Q + (size_t)r * 1024 : Kb + (size_t)(b * KVLEN + (lat ? t : SEQ + t)) * 1024;
                EPI_BJ {
                    f32x4 o[2];
#pragma unroll
                    for (int n = 0; n < 2; ++n)
#pragma unroll
                        for (int i = 0; i < 4; ++i) { const float v = acc[ai][bj][m][n][i]; const float pv = __shfl_xor(v, 32); const int e = n * 4 + i;
                            const float cc = cs[e >> 1][(e & 1) * 2], ss = cs[e >> 1][(e & 1) * 2 + 1]; o[n][i] = v * cc + sgn * pv * ss; }
                    if (isq) { o[0] = o[0] * QSCALE; o[1] = o[1] * QSCALE; }
                    const int col0 = (pn - (isq ? 4 : 8)) * 256 + bj * 128 + wc * 32 + fq * 8;
                    *(u32x4*)(dst + col0) = pk8(o[0], o[1]);
                }
            } else if (pn < 16) {
                const int kvpos = lat ? t : SEQ + t;
                EPI_BJ { const int colv = (pn - 12) * 256 + bj * 128 + wc * 32 + fq * 8; bf16_t* p = Vt + (size_t)(b * 1024 + colv) * KVLEN + kvpos;
                    const f32x4 v0 = acc[ai][bj][m][0], v1 = acc[ai][bj][m][1];
                    p[0] = f2bf1(v0[0]); p[KVLEN] = f2bf1(v0[1]); p[2 * KVLEN] = f2bf1(v0[2]); p[3 * KVLEN] = f2bf1(v0[3]);
                    p[4 * KVLEN] = f2bf1(v1[0]); p[5 * KVLEN] = f2bf1(v1[1]); p[6 * KVLEN] = f2bf1(v1[2]); p[7 * KVLEN] = f2bf1(v1[3]); }
            } else {
                bf16_t* dst = (pn < 24 ? SGs : SGa) + (size_t)r * 2048 + (pn - (pn < 24 ? 16 : 24)) * 256;
                EPI_BJ { const int col = bj * 128 + wc * 32 + fq * 8; *(u32x4*)(dst + col) = pk8(sig4(acc[ai][bj][m][0]), sig4(acc[ai][bj][m][1])); }
            }
        }
    }
};
struct EpiSsm1 {
    static constexpr bool MID = false;
    float* S;
    DI void operator()(EPI_ARGS) const {
        EPI_ROWS { const int r = u.pm * 256 + wr * 64 + fr + ai * 128 + m * 16; float* rowp = S + ((size_t)u.bz * UROWS_PAD + r) * 256;
            EPI_BJ { const int col = bj * 128 + wc * 32 + fq * 8; *(f32x4*)(rowp + col) = acc[ai][bj][m][0]; *(f32x4*)(rowp + col + 4) = acc[ai][bj][m][1]; } }
    }
};
DI float gelu_tanh(float y) { const float a = 1.5957691216057308f * (y + 0.044715f * y * y * y); return y * sigmoidf_(a); }
DI f32x4 gelu4(const f32x4 v) { f32x4 z; z[0] = gelu_tanh(v[0]); z[1] = gelu_tanh(v[1]); z[2] = gelu_tanh(v[2]); z[3] = gelu_tanh(v[3]); return z; }
struct EpiSsm3 {
    static constexpr bool MID = false;
    bf16_t* Z;
    DI void operator()(EPI_ARGS) const {
        EPI_ROWS { const int r = u.pm * 256 + wr * 64 + fr + ai * 128 + m * 16;
            EPI_BJ { const int coln = u.pn * 256 + bj * 128 + wc * 32 + fq * 8; const int t = coln >> 4, c = coln & 15;
                *(u32x4*)(Z + (size_t)(r * TCH + t) * 1024 + u.bz * 16 + c) = pk8(gelu4(acc[ai][bj][m][0]), gelu4(acc[ai][bj][m][1])); } }
    }
};
struct EpiGlu {
    static constexpr bool MID = false;
    const bf16_t* Z; const float* bglu; bf16_t* Y;
    DI void operator()(EPI_ARGS) const {
        EPI_ROWS { const int r = u.pm * 256 + wr * 64 + fr + ai * 128 + m * 16;
            EPI_BJ { const int col = u.pn * 256 + bj * 128 + wc * 32 + fq * 8; const f32x4 b0 = *(const f32x4*)(bglu + col), b1 = *(const f32x4*)(bglu + col + 4);
                f32x4 z0, z1; unpk8(*(const u32x4*)(Z + (size_t)r * 1024 + col), z0, z1);
                *(u32x4*)(Y + (size_t)r * 2048 + col) = pk8(z0 * sig4(acc[ai][bj][m][0] + b0), z1 * sig4(acc[ai][bj][m][1] + b1)); } }
    }
};
struct EpiProj1 {
    static constexpr bool MID = false;
    const bf16_t* SG; bf16_t* tmp;
    DI void operator()(EPI_ARGS) const {
        EPI_ROWS { const int r = u.pm * 256 + wr * 64 + fr + ai * 128 + m * 16;
            EPI_BJ { const int col = u.pn * 256 + bj * 128 + wc * 32 + fq * 8; f32x4 s0, s1; unpk8(*(const u32x4*)(SG + (size_t)r * 2048 + col), s0, s1);
                *(u32x4*)(tmp + (size_t)r * 2048 + col) = pk8(s0 * acc[ai][bj][m][0], s1 * acc[ai][bj][m][1]); } }
    }
};
struct EpiProj2 {
    static constexpr bool MID = false;
    const bf16_t* SG; const bf16_t* tmp; bf16_t* Mg;
    DI void operator()(EPI_ARGS) const {
        EPI_ROWS { const int r = u.pm * 256 + wr * 64 + fr + ai * 128 + m * 16;
            EPI_BJ { const int col = u.pn * 256 + bj * 128 + wc * 32 + fq * 8; f32x4 s0, s1, t0, t1; unpk8(*(const u32x4*)(SG + (size_t)r * 2048 + col), s0, s1);
                unpk8(*(const u32x4*)(tmp + (size_t)r * 2048 + col), t0, t1);
                *(u32x4*)(Mg + (size_t)r * 2048 + col) = pk8(t0 + s0 * acc[ai][bj][m][0], t1 + s1 * acc[ai][bj][m][1]); } }
    }
};
struct EpiMerge {
    static constexpr bool MID = true;
    const bf16_t* SGs; const bf16_t* SGa; bf16_t* Mg;
    DI void mid(f32x4 (&acc)[2][2][4][2], const Unit& u, int wr, int wc, int fr, int fq) const {
        EPI_ROWS { const int r = u.pm * 256 + wr * 64 + fr + ai * 128 + m * 16;
            EPI_BJ { const int col = u.pn * 256 + bj * 128 + wc * 32 + fq * 8; f32x4 s0, s1, a0, a1; unpk8(*(const u32x4*)(SGs + (size_t)r * 2048 + col), s0, s1); unpk8(*(const u32x4*)(SGa + (size_t)r * 2048 + col), a0, a1);
#pragma unroll
                for (int i = 0; i < 4; ++i) { acc[ai][bj][m][0][i] *= s0[i] * __builtin_amdgcn_rcpf(fmaxf(a0[i], 1e-20f)); acc[ai][bj][m][1][i] *= s1[i] * __builtin_amdgcn_rcpf(fmaxf(a1[i], 1e-20f)); }
                asm volatile("" ::: "memory"); } }
    }
    DI void operator()(EPI_ARGS) const {
        EPI_ROWS { const int r = u.pm * 256 + wr * 64 + fr + ai * 128 + m * 16;
            EPI_BJ { const int col = u.pn * 256 + bj * 128 + wc * 32 + fq * 8; f32x4 a0, a1; unpk8(*(const u32x4*)(SGa + (size_t)r * 2048 + col), a0, a1);
                *(u32x4*)(Mg + (size_t)r * 2048 + col) = pk8(a0 * acc[ai][bj][m][0], a1 * acc[ai][bj][m][1]); } }
    }
};
struct EpiResid {
    static constexpr bool MID = false;
    const float* base; const float* gate; float* out;
    DI void operator()(EPI_ARGS) const {
        EPI_ROWS { const int r = u.pm * 256 + wr * 64 + fr + ai * 128 + m * 16; const float* gp = gate + (size_t)(r >> 11) * NMOD;
            EPI_BJ { const int col = u.pn * 256 + bj * 128 + wc * 32 + fq * 8; const f32x4 g0 = *(const f32x4*)(gp + col), g1 = *(const f32x4*)(gp + col + 4);
                const float* bp = base + (size_t)r * 2048 + col; const f32x4 b0 = *(const f32x4*)(bp), b1 = *(const f32x4*)(bp + 4);
                float* op = out + (size_t)r * 2048 + col; *(f32x4*)(op) = b0 + g0 * acc[ai][bj][m][0]; *(f32x4*)(op + 4) = b1 + g1 * acc[ai][bj][m][1]; } }
    }
};
struct EpiFfnIn {
    static constexpr bool MID = false;
    bf16_t* Hd;
    DI void operator()(EPI_ARGS) const {
        EPI_ROWS { const int r = u.pm * 256 + wr * 64 + fr + ai * 128 + m * 16;
            const int col = u.pn * 128 + wc * 32 + fq * 8;
            const f32x4 g0 = acc[ai][0][m][0], g1 = acc[ai][0][m][1];
            *(u32x4*)(Hd + (size_t)r * DFF + col) = pk8(g0 * sig4(g0) * acc[ai][1][m][0], g1 * sig4(g1) * acc[ai][1][m][1]); }
    }
};
}

namespace att {
constexpr int KROWB = 272, VROWB = 144, KT_BYTES = 64 * KROWB, VT_BYTES = 128 * VROWB, BUF = KT_BYTES + VT_BYTES, XCH_OFF = 2 * BUF;
#define MFMA32(a, b, c) __builtin_amdgcn_mfma_f32_32x32x16_bf16((a), (b), (c), 0, 0, 0)
DI void attn_phase(LAS unsigned char* lds, const bf16_t* Q, const bf16_t* Kb, const bf16_t* Vt, bf16_t* O, const float* subln, const float* lamp, int G, int cblk) {
    const int tid = threadIdx.x, lane = tid & 63, w = __builtin_amdgcn_readfirstlane(tid >> 6), q32 = lane & 31, hi = lane >> 5;
    const int map = w >> 2;
    const float lam = lamp[0];
    const int krow = (q32 & ~12) | ((q32 & 4) << 1) | ((q32 & 8) >> 1);
    const int kdst = (tid >> 4) * KROWB + (tid & 15) * 16;
    const int vdst = KT_BYTES + (tid >> 3) * VROWB + (tid & 7) * 16;
    const int kfo = krow * KROWB + (map * 64 + hi * 8) * 2;
    const int vfo = KT_BYTES + q32 * VROWB + hi * 16;
    const int vcu = (G % 8 == 0) ? (cblk % 8) * (G / 8) + cblk / 8 : cblk;
    for (int L = vcu; L < NB * 8 * 16; L += G) {
        const int bh = L >> 4, qb = L & 15, b = bh >> 3, h = bh & 7;
        const int qrow = b * SEQ + qb * 128 + (w & 3) * 32 + q32;
        bf16x8 qf[4];
        { const bf16_t* qp = Q + (size_t)qrow * 1024 + h * 128 + map * 64 + hi * 8;
#pragma unroll
          for (int ds = 0; ds < 4; ++ds) qf[ds] = *(const bf16x8*)(qp + ds * 16); }
        const bf16_t* ksrc = Kb + ((size_t)(b * KVLEN) + (tid >> 4)) * 1024 + h * 128 + (tid & 15) * 8;
        const bf16_t* vsrc = Vt + ((size_t)(bh * 128) + (tid >> 3)) * KVLEN + (tid & 7) * 8;
        u32x4 kr0, kr1, vr0, vr1;
        kr0 = *(const u32x4*)(ksrc); kr1 = *(const u32x4*)(ksrc + 32 * 1024); vr0 = *(const u32x4*)(vsrc); vr1 = *(const u32x4*)(vsrc + (size_t)64 * KVLEN);
        *(LAS u32x4*)(lds + kdst) = kr0; *(LAS u32x4*)(lds + kdst + 32 * KROWB) = kr1; *(LAS u32x4*)(lds + vdst) = vr0; *(LAS u32x4*)(lds + vdst + 64 * VROWB) = vr1;
        __syncthreads();
        f32x16 o[4];
#pragma unroll
        for (int db = 0; db < 4; ++db)
#pragma unroll
            for (int r = 0; r < 16; ++r) o[db][r] = 0.f;
        float mrun = -1e30f, lsum = 0.f;
        for (int t = 0; t < KVLEN / 64; ++t) {
            const bool more = (t + 1 < KVLEN / 64);
            if (more) { const bf16_t* kp = ksrc + (size_t)(t + 1) * 64 * 1024; const bf16_t* vp = vsrc + (t + 1) * 64;
                kr0 = *(const u32x4*)(kp); kr1 = *(const u32x4*)(kp + 32 * 1024); vr0 = *(const u32x4*)(vp); vr1 = *(const u32x4*)(vp + (size_t)64 * KVLEN); }
            LAS unsigned char* bufp = lds + (t & 1) * BUF;
            f32x16 st[2];
            bf16x8 kf[8];
#pragma unroll
            for (int i = 0; i < 8; ++i) kf[i] = *(const LAS bf16x8*)(bufp + kfo + (i >> 2) * 32 * KROWB + (i & 3) * 32);
            __builtin_amdgcn_sched_barrier(0);
#pragma unroll
            for (int r = 0; r < 16; ++r) { st[0][r] = 0.f; st[1][r] = 0.f; }
#pragma unroll
            for (int ds = 0; ds < 4; ++ds) { st[0] = MFMA32(kf[ds], qf[ds], st[0]); st[1] = MFMA32(kf[4 + ds], qf[ds], st[1]); }
            bf16x8 vf[16];
#pragma unroll
            for (int i = 0; i < 8; ++i) vf[i] = *(const LAS bf16x8*)(bufp + vfo + (i & 3) * 32 * VROWB + (i >> 2) * 32);
            __builtin_amdgcn_sched_barrier(0);
            float mx = st[0][0];
#pragma unroll
            for (int r = 1; r < 16; ++r) mx = fmaxf(mx, st[0][r]);
#pragma unroll
            for (int r = 0; r < 16; ++r) mx = fmaxf(mx, st[1][r]);
            mx = fmaxf(mx, __shfl_xor(mx, 32));
            if (__any(mx > mrun + 8.f)) {
                const float mn = fmaxf(mrun, mx); const float al = __builtin_amdgcn_exp2f(mrun - mn); lsum *= al; mrun = mn;
#pragma unroll
                for (int db = 0; db < 4; ++db)
#pragma unroll
                    for (int r = 0; r < 16; ++r) o[db][r] *= al;
            }
            float ps = 0.f;
#pragma unroll
            for (int kb = 0; kb < 2; ++kb)
#pragma unroll
                for (int r = 0; r < 16; ++r) { const float p = __builtin_amdgcn_exp2f(st[kb][r] - mrun); st[kb][r] = p; ps += p; }
            lsum += ps;
#pragma unroll
            for (int i = 8; i < 16; ++i) vf[i] = *(const LAS bf16x8*)(bufp + vfo + (i & 3) * 32 * VROWB + (i >> 2) * 32);
#pragma unroll
            for (int kb = 0; kb < 2; ++kb)
#pragma unroll
                for (int s = 0; s < 2; ++s) {
                    u32x4 pw; pw.x = pk2(st[kb][8 * s + 0], st[kb][8 * s + 1]); pw.y = pk2(st[kb][8 * s + 2], st[kb][8 * s + 3]); pw.z = pk2(st[kb][8 * s + 4], st[kb][8 * s + 5]); pw.w = pk2(st[kb][8 * s + 6], st[kb][8 * s + 7]);
                    const bf16x8 pb = __builtin_bit_cast(bf16x8, pw);
#pragma unroll
                    for (int db = 0; db < 4; ++db) o[db] = MFMA32(vf[(kb * 2 + s) * 4 + db], pb, o[db]);
                }
            if (more) { LAS unsigned char* nb = lds + ((t + 1) & 1) * BUF;
                *(LAS u32x4*)(nb + kdst) = kr0; *(LAS u32x4*)(nb + kdst + 32 * KROWB) = kr1; *(LAS u32x4*)(nb + vdst) = vr0; *(LAS u32x4*)(nb + vdst + 64 * VROWB) = vr1; }
            __syncthreads();
        }
        lsum += __shfl_xor(lsum, 32);
        const float inv = 1.f / lsum;
        LAS float* xp = (LAS float*)(lds + XCH_OFF) + ((w & 3) * 64) * 64 + lane;
        if (map == 1) {
#pragma unroll
            for (int db = 0; db < 4; ++db)
#pragma unroll
                for (int r = 0; r < 16; ++r) xp[(db * 16 + r) * 64] = o[db][r] * inv;
        }
        __syncthreads();
        if (map == 0) {
            float ss = 0.f;
#pragma unroll
            for (int db = 0; db < 4; ++db)
#pragma unroll
                for (int r = 0; r < 16; ++r) { const float v = o[db][r] * inv - lam * xp[(db * 16 + r) * 64]; o[db][r] = v; ss += v * v; }
            ss += __shfl_xor(ss, 32);
            const float rstd = rsqrtf(ss * (1.f / 128.f) + 1e-6f) * 0.8f;
            bf16_t* op = O + (size_t)qrow * 2048 + 1024 + h * 128;
#pragma unroll
            for (int db = 0; db < 4; ++db)
#pragma unroll
                for (int r4 = 0; r4 < 4; ++r4) { const int d0 = 32 * db + 8 * r4 + 4 * hi; const f32x4 gv = *(const f32x4*)(subln + d0); f32x4 v;
                    v[0] = o[db][4 * r4 + 0] * rstd * gv[0]; v[1] = o[db][4 * r4 + 1] * rstd * gv[1]; v[2] = o[db][4 * r4 + 2] * rstd * gv[2]; v[3] = o[db][4 * r4 + 3] * rstd * gv[3];
                    *(u32x2*)(op + d0) = pk4(v); }
        }
    }
}
}

#define XB_TMO      128
#define XB_XCNT(j)  (256  + 64 * (j))
#define XB_XSUB(j)  (1280 + 64 * (j))
#define XB_XGEN(j)  (2304 + 64 * (j))
#define XB_TOP      3328
#define XB_TOPGEN   3392
#define XCD_BAR_WORDS 3456
#define XB_SPIN_CAP (1u << 18)

__device__ __forceinline__ unsigned xb_ld(unsigned* p)              { return __hip_atomic_load(p, __ATOMIC_RELAXED, __HIP_MEMORY_SCOPE_AGENT); }
__device__ __forceinline__ unsigned xb_add(unsigned* p, unsigned v) { return __hip_atomic_fetch_add(p, v, __ATOMIC_RELAXED, __HIP_MEMORY_SCOPE_AGENT); }
__device__ __forceinline__ unsigned xb_xcc_id() { return (unsigned)__builtin_amdgcn_s_getreg((3 << 11) | 20) & 0xFu; }
#define XB_SPIN(cond, bar) do { unsigned _sp = 0; while (cond) { __builtin_amdgcn_s_sleep(1); \
    if ((++_sp & 255u) == 0u) { if (xb_ld(&(bar)[XB_TMO])) break; if (_sp > XB_SPIN_CAP) { atomicAdd(&(bar)[XB_TMO], 1u); break; } } } } while (0)

struct XcdBarrier {
    unsigned* bar; unsigned x;
    volatile LAS unsigned* st;
};

__device__ __forceinline__ XcdBarrier xcd_barrier_post(unsigned* bar, volatile LAS unsigned* st) {
    XcdBarrier b; b.bar = bar; b.x = xb_xcc_id(); b.st = st;
    if (threadIdx.x == 0) (void)xb_add(&bar[XB_XCNT(b.x)], 1u);
    return b;
}
__device__ __forceinline__ void xcd_barrier_complete(unsigned* bar, unsigned x, unsigned& nloc, unsigned& nx) {
    const unsigned G = gridDim.x * gridDim.y * gridDim.z;
    unsigned sum, cnt, mine, sp = 0u;
    for (;;) {
        sum = 0u; cnt = 0u; mine = 0u;
#pragma unroll
        for (unsigned j = 0; j < 16; ++j) { const unsigned c = xb_ld(&bar[XB_XCNT(j)]); sum += c; cnt += (c > 0u) ? 1u : 0u; mine = (j == x) ? c : mine; }
        if (sum == G) break;
        __builtin_amdgcn_s_sleep(1);
        if ((++sp & 255u) == 0u) { if (xb_ld(&bar[XB_TMO])) break; if (sp > XB_SPIN_CAP) { atomicAdd(&bar[XB_TMO], 1u); break; } }
    }
    nloc = mine > 0u ? mine : 1u; nx = cnt > 0u ? cnt : 1u;
}

__device__ __forceinline__ void xcd_barrier(const XcdBarrier& b) {
    asm volatile("s_waitcnt vmcnt(0)" ::: "memory");
    __syncthreads();
    if (threadIdx.x == 0) {
        unsigned* bar = b.bar;
        __builtin_amdgcn_s_waitcnt(0);
        unsigned nloc = b.st[0], nx = b.st[1];
        if (nloc == 0u) { xcd_barrier_complete(bar, b.x, nloc, nx); b.st[0] = nloc; b.st[1] = nx; }
        const unsigned old = xb_add(&bar[XB_XSUB(b.x)], 1u);
        const unsigned gen = old / nloc;
        if (old + 1u == (gen + 1u) * nloc) {
            __builtin_amdgcn_fence(__ATOMIC_RELEASE, "agent");
            asm volatile("s_waitcnt vmcnt(0)" ::: "memory");
            const unsigned og = xb_add(&bar[XB_TOP], 1u);
            const unsigned tg = og / nx;
            if (og + 1u == (tg + 1u) * nx) xb_add(&bar[XB_TOPGEN], 1u);
            else XB_SPIN(xb_ld(&bar[XB_TOPGEN]) == tg, bar);
            __builtin_amdgcn_fence(__ATOMIC_ACQUIRE, "agent");
            xb_add(&bar[XB_XGEN(b.x)], 1u);
            asm volatile("s_waitcnt vmcnt(0)" ::: "memory");
        } else {
            XB_SPIN(xb_ld(&bar[XB_XGEN(b.x)]) == gen, bar);
            __builtin_amdgcn_fence(__ATOMIC_ACQUIRE, "agent");
            asm volatile("s_waitcnt vmcnt(0)" ::: "memory");
        }
    }
    __syncthreads();
}

struct Args { const float* in[30]; float* out; unsigned char* ws; int ph_lo, ph_hi, seg, pad; };

DI void transpose_item(const float* W, int K, int Nsrc, bf16_t* WT, int dest_n0, int src_n0, int k0, LAS float* scr, int lane) {
#pragma unroll 8
    for (int i = 0; i < 32; ++i) { const int kk = 2 * i + (lane >> 5); scr[kk * 33 + (lane & 31)] = W[(size_t)(k0 + kk) * Nsrc + src_n0 + (lane & 31)]; }
    asm volatile("s_waitcnt lgkmcnt(0)" ::: "memory");
    const int c = lane & 7;
#pragma unroll
    for (int j = 0; j < 4; ++j) { const int n = (lane >> 3) + 8 * j; const LAS float* s = scr + (8 * c) * 33 + n;
        u32x4 o; o.x = pk2(s[0 * 33], s[1 * 33]); o.y = pk2(s[2 * 33], s[3 * 33]); o.z = pk2(s[4 * 33], s[5 * 33]); o.w = pk2(s[6 * 33], s[7 * 33]);
        *(u32x4*)(WT + (size_t)(dest_n0 + n) * K + k0 + 8 * c) = o; }
    asm volatile("s_waitcnt lgkmcnt(0)" ::: "memory");
}

DI void mod_item(LAS unsigned char* lds, const float* cvec, const float* cctx, const float* wada, const float* bada, float* mod, int it) {
    const int tid = threadIdx.x, lane = tid & 63, w = tid >> 6;
    LAS float* sl = (LAS float*)lds + w * (17 * 256);
    for (int idx = lane; idx < 17 * 256; idx += 64) { const int r = idx >> 8, kk = idx & 255; const float cv = (r < 16) ? cvec[r * DM + 256 * w + kk] : cctx[256 * w + kk]; sl[idx] = cv * sigmoidf_(cv); }
    asm volatile("s_waitcnt lgkmcnt(0)" ::: "memory");
    const int col = it * 64 + lane;
    float acc[17];
#pragma unroll
    for (int r = 0; r < 17; ++r) acc[r] = 0.f;
    const float* wp = wada + (size_t)(256 * w) * NMOD + col;
    for (int kk = 0; kk < 256; kk += 8) {
        float wv[8];
#pragma unroll
        for (int e = 0; e < 8; ++e) wv[e] = wp[(size_t)(kk + e) * NMOD];
#pragma unroll
        for (int r = 0; r < 17; ++r) { const f32x4 s0 = *(const LAS f32x4*)(sl + r * 256 + kk), s1 = *(const LAS f32x4*)(sl + r * 256 + kk + 4);
            acc[r] += s0[0] * wv[0] + s0[1] * wv[1] + s0[2] * wv[2] + s0[3] * wv[3] + s1[0] * wv[4] + s1[1] * wv[5] + s1[2] * wv[6] + s1[3] * wv[7]; }
    }
    __syncthreads();
    LAS float* red = (LAS float*)lds;
#pragma unroll
    for (int r = 0; r < 17; ++r) red[(w * 17 + r) * 64 + lane] = acc[r];
    __syncthreads();
    for (int idx = tid; idx < 17 * 64; idx += NTHREADS) { const int r = idx >> 6, l = idx & 63; float s = bada[it * 64 + l];
#pragma unroll
        for (int ww = 0; ww < 8; ++ww) s += red[(ww * 17 + r) * 64 + l];
        mod[(size_t)r * NMOD + it * 64 + l] = s; }
    __syncthreads();
}

DI void transpose_tile64(const float* W, int K, int Nsrc, bf16_t* WT, int dest_n0, int src_n0, int k0, LAS float* scr, int lane) {
    f32x4 v[16];
    const float* src = W + (size_t)(k0 + (lane >> 4)) * Nsrc + src_n0 + (lane & 15) * 4;
#pragma unroll
    for (int i = 0; i < 16; ++i) v[i] = *(const f32x4*)(src + (size_t)(4 * i) * Nsrc);
#pragma unroll
    for (int i = 0; i < 16; ++i) { LAS float* p = scr + (4 * i + (lane >> 4)) * 65 + (lane & 15) * 4; p[0] = v[i][0]; p[1] = v[i][1]; p[2] = v[i][2]; p[3] = v[i][3]; }
    asm volatile("s_waitcnt lgkmcnt(0)" ::: "memory");
    const int c = lane & 7;
#pragma unroll
    for (int j = 0; j < 8; ++j) { const int n = (lane >> 3) + 8 * j; const LAS float* s = scr + (8 * c) * 65 + n;
        u32x4 o; o.x = pk2(s[0 * 65], s[1 * 65]); o.y = pk2(s[2 * 65], s[3 * 65]); o.z = pk2(s[4 * 65], s[5 * 65]); o.w = pk2(s[6 * 65], s[7 * 65]);
        *(u32x4*)(WT + (size_t)(dest_n0 + n) * K + k0 + 8 * c) = o; }
    asm volatile("s_waitcnt lgkmcnt(0)" ::: "memory");
}

DI void mod_item128(LAS unsigned char* lds, const float* cvec, const float* cctx, const float* wada, const float* bada, float* mod, int it) {
    const int tid = threadIdx.x, lane = tid & 63, w = tid >> 6;
    LAS float* sl = (LAS float*)lds + w * (17 * 256);
    for (int idx = lane; idx < 17 * 256; idx += 64) { const int r = idx >> 8, kk = idx & 255; const float cv = (r < 16) ? cvec[r * DM + 256 * w + kk] : cctx[256 * w + kk]; sl[idx] = cv * sigmoidf_(cv); }
    asm volatile("s_waitcnt lgkmcnt(0)" ::: "memory");
    const int col = it * 128 + 2 * lane;
    float a0[17], a1[17];
#pragma unroll
    for (int r = 0; r < 17; ++r) { a0[r] = 0.f; a1[r] = 0.f; }
    const float* wp = wada + (size_t)(256 * w) * NMOD + col;
    for (int kk = 0; kk < 256; kk += 32) {
        f32x2_t wv[32];
#pragma unroll
        for (int e = 0; e < 32; ++e) wv[e] = *(const f32x2_t*)(wp + (size_t)(kk + e) * NMOD);
#pragma unroll
        for (int r = 0; r < 17; ++r) {
#pragma unroll
            for (int q = 0; q < 8; ++q) { const f32x4 s4 = *(const LAS f32x4*)(sl + r * 256 + kk + 4 * q);
                a0[r] += s4[0] * wv[4 * q][0] + s4[1] * wv[4 * q + 1][0] + s4[2] * wv[4 * q + 2][0] + s4[3] * wv[4 * q + 3][0];
                a1[r] += s4[0] * wv[4 * q][1] + s4[1] * wv[4 * q + 1][1] + s4[2] * wv[4 * q + 2][1] + s4[3] * wv[4 * q + 3][1]; }
        }
    }
    __syncthreads();
    LAS float* red = (LAS float*)lds;
#pragma unroll
    for (int r = 0; r < 17; ++r) { red[(w * 17 + r) * 128 + 2 * lane] = a0[r]; red[(w * 17 + r) * 128 + 2 * lane + 1] = a1[r]; }
    __syncthreads();
    for (int idx = tid; idx < 17 * 128; idx += NTHREADS) { const int r = idx >> 7, c = idx & 127; float s = bada[it * 128 + c];
#pragma unroll
        for (int ww = 0; ww < 8; ++ww) s += red[(ww * 17 + r) * 128 + c];
        mod[(size_t)r * NMOD + it * 128 + c] = s; }
}

DI void ssm_coef_item(LAS unsigned char* lds, const float* const* in, bf16_t* Bt3, bf16_t* Bt1, float* lamT, int g) {
    const int tid = threadIdx.x;
    LAS float* Lam = (LAS float*)lds;
    LAS float* Bb = Lam + 2 * 33 * 64 * 2;
    LAS float* Cm = Bb + 2 * 64 * 16 * 2;
    LAS float* Km = Cm + 2 * 16 * 130;
    const float* a_re = in[8]; const float* a_im = in[9]; const float* log_dt = in[10]; const float* b_re = in[11]; const float* b_im = in[12];
    const float* c_re = in[13]; const float* c_im = in[14]; const float* dsk = in[15];
    if (tid < 128) {
        const int d = tid >> 6, p = tid & 63;
        const double dt = exp((double)log_dt[d * 64 + g]); const double lr = (double)a_re[(d * 64 + g) * 64 + p], li = (double)a_im[(d * 64 + g) * 64 + p];
        const double zr = lr * dt, zi = li * dt; const double mag = exp(zr); double rev = zi * 0.15915494309189535; rev -= floor(rev + 0.5); const double ang = rev * 6.283185307179586;
        const double er = mag * cos(ang), ei = mag * sin(ang);
        double pr = 1.0, pi = 0.0;
        for (int j = 0; j <= 32; ++j) { Lam[((d * 33 + j) * 64 + p) * 2] = (float)pr; Lam[((d * 33 + j) * 64 + p) * 2 + 1] = (float)pi; const double nr = pr * er - pi * ei, ni = pr * ei + pi * er; pr = nr; pi = ni; }
        const double den = lr * lr + li * li; const double e1 = er - 1.0; const double fr_ = (e1 * lr + ei * li) / den, fi_ = (ei * lr - e1 * li) / den;
        const float* brp = b_re + ((size_t)(d * 64 + g) * 64 + p) * 16; const float* bip = b_im + ((size_t)(d * 64 + g) * 64 + p) * 16;
#pragma unroll
        for (int c = 0; c < 16; ++c) { const double br = (double)brp[c], bi = (double)bip[c]; Bb[((d * 64 + p) * 16 + c) * 2] = (float)(fr_ * br - fi_ * bi); Bb[((d * 64 + p) * 16 + c) * 2 + 1] = (float)(fr_ * bi + fi_ * br); }
    }
    for (int idx = tid; idx < 2 * 16 * 64; idx += NTHREADS) { const int p = idx & 63, c = (idx >> 6) & 15, d = idx >> 10;
        Cm[(d * 16 + c) * 130 + p * 2] = c_re[((d * 64 + g) * 16 + c) * 64 + p]; Cm[(d * 16 + c) * 130 + p * 2 + 1] = c_im[((d * 64 + g) * 16 + c) * 64 + p]; }
    __syncthreads();
    {
        const int q4 = tid & 3, c = (tid >> 2) & 15, djl = tid >> 6;
        for (int rnd = 0; rnd < 8; ++rnd) {
            const int dj = rnd * 8 + djl, d = dj >> 5, j = dj & 31;
            float a0 = 0.f, a1 = 0.f, a2 = 0.f, a3 = 0.f;
            const LAS float* cmp = Cm + (d * 16 + c) * 130; const LAS float* lmp = Lam + ((d * 33 + j) * 64) * 2; const LAS float* bbp = Bb + (d * 64 * 16 + 4 * q4) * 2;
#pragma unroll 4
            for (int p = 0; p < 64; ++p) {
                const f32x2_t cv = *(const LAS f32x2_t*)(cmp + p * 2), lv = *(const LAS f32x2_t*)(lmp + p * 2);
                const f32x4 b01 = *(const LAS f32x4*)(bbp + p * 32), b23 = *(const LAS f32x4*)(bbp + p * 32 + 4);
                const float vr = cv[0] * lv[0] - cv[1] * lv[1], vi = cv[0] * lv[1] + cv[1] * lv[0];
                a0 += vr * b01[0] - vi * b01[1]; a1 += vr * b01[2] - vi * b01[3]; a2 += vr * b23[0] - vi * b23[1]; a3 += vr * b23[2] - vi * b23[3];
            }
            *(LAS f32x4*)(Km + ((d * 32 + j) * 16 + c) * 16 + 4 * q4) = (f32x4){a0, a1, a2, a3};
        }
    }
    __syncthreads();
    bf16_t* B3 = Bt3 + (size_t)g * 512 * UK;
    for (int idx = tid; idx < 512 * 96; idx += NTHREADS) {
        const int n = idx / 96, k0 = (idx % 96) * 8; const int t = n >> 4, c = n & 15;
        float v[8];
        if (k0 < 512) {
            const int s = k0 >> 4, c0 = k0 & 15;
#pragma unroll
            for (int e = 0; e < 8; ++e) { const int cp = c0 + e; float x;
                if (s < t) x = Km[((0 * 32 + (t - s)) * 16 + c) * 16 + cp];
                else if (s > t) x = Km[((1 * 32 + (s - t)) * 16 + c) * 16 + cp];
                else x = Km[(c) * 16 + cp] + Km[((32) * 16 + c) * 16 + cp] + (c == cp ? dsk[g * 16 + c] : 0.f);
                v[e] = x; }
        } else {
            const int kk = k0 - 512, sec = kk >> 6, p0 = kk & 63, d = sec >> 1, part = sec & 1; const int jj = d == 0 ? t + 1 : TCH - t;
#pragma unroll
            for (int e = 0; e < 8; ++e) { const int p = p0 + e;
                const float cr = Cm[(d * 16 + c) * 130 + p * 2], ci = Cm[(d * 16 + c) * 130 + p * 2 + 1];
                const float lr = Lam[((d * 33 + jj) * 64 + p) * 2], li = Lam[((d * 33 + jj) * 64 + p) * 2 + 1];
                v[e] = part == 0 ? (cr * lr - ci * li) : -(cr * li + ci * lr); }
        }
        u32x4 o; o.x = pk2(v[0], v[1]); o.y = pk2(v[2], v[3]); o.z = pk2(v[4], v[5]); o.w = pk2(v[6], v[7]);
        *(u32x4*)(B3 + (size_t)n * UK + k0) = o;
    }
    bf16_t* B1 = Bt1 + (size_t)g * 256 * 512;
    for (int idx = tid; idx < 256 * 64; idx += NTHREADS) {
        const int n = idx >> 6, k0 = (idx & 63) * 8; const int s = k0 >> 4, c0 = k0 & 15; const int d = n >> 7, part = (n >> 6) & 1, p = n & 63;
        const int ee = d == 0 ? (TCH - 1 - s) : s;
        const float lr = Lam[((d * 33 + ee) * 64 + p) * 2], li = Lam[((d * 33 + ee) * 64 + p) * 2 + 1];
        float v[8];
#pragma unroll
        for (int e = 0; e < 8; ++e) { const float br = Bb[((d * 64 + p) * 16 + c0 + e) * 2], bi = Bb[((d * 64 + p) * 16 + c0 + e) * 2 + 1]; v[e] = part == 0 ? (lr * br - li * bi) : (lr * bi + li * br); }
        u32x4 o; o.x = pk2(v[0], v[1]); o.y = pk2(v[2], v[3]); o.z = pk2(v[4], v[5]); o.w = pk2(v[6], v[7]);
        *(u32x4*)(B1 + (size_t)n * 512 + k0) = o;
    }
    for (int idx = tid; idx < 128; idx += NTHREADS) { const int d = idx >> 6, p = idx & 63; lamT[((g * 2 + d) * 64 + p) * 2] = Lam[((d * 33 + 32) * 64 + p) * 2]; lamT[((g * 2 + d) * 64 + p) * 2 + 1] = Lam[((d * 33 + 32) * 64 + p) * 2 + 1]; }
    __syncthreads();
}

DI void normmod_row(const float* xr, const float* gv, const float* sh, const float* sc, bf16_t* orow, int lane) {
    f32x4 v[8]; float ss = 0.f;
#pragma unroll
    for (int j = 0; j < 8; ++j) { v[j] = *(const f32x4*)(xr + 4 * lane + 256 * j); ss += (v[j][0] * v[j][0] + v[j][1] * v[j][1]) + (v[j][2] * v[j][2] + v[j][3] * v[j][3]); }
    const float rstd = rsqrtf(wave_sum(ss) * (1.f / DM) + 1e-6f);
#pragma unroll
    for (int j = 0; j < 8; ++j) { const int c = 4 * lane + 256 * j; const f32x4 g4 = *(const f32x4*)(gv + c), s4 = *(const f32x4*)(sh + c), c4 = *(const f32x4*)(sc + c);
        const f32x4 y = (v[j] * rstd * g4) * (c4 + 1.f) + s4; *(u32x2*)(orow + c) = pk4(y); }
}

constexpr int NPH = 14;
__global__ void __launch_bounds__(NTHREADS, 2) fwd_kernel(Args args) {
    extern __shared__ __attribute__((aligned(16))) unsigned char lds_raw[];
    LAS unsigned char* lds = (LAS unsigned char*)lds_raw;
    cg::grid_group grid = cg::this_grid();
    const int tid = threadIdx.x, lane = tid & 63, wave = __builtin_amdgcn_readfirstlane(tid >> 6);
    const int G = gridDim.x, cb = blockIdx.x;
    const int gw = cb * 8 + wave, NGW = G * 8;
    unsigned char* ws = args.ws;
    const float* x = args.in[0]; float* out = args.out;
#define Wt_in ((bf16_t*)(ws + WS_WIN))
#define Wt_glu ((bf16_t*)(ws + WS_WGLU))
#define Wt_ps ((bf16_t*)(ws + WS_WPS))
#define Wt_pa ((bf16_t*)(ws + WS_WPA))
#define Wt_out ((bf16_t*)(ws + WS_WOUT))
#define Wt_fi ((bf16_t*)(ws + WS_WFI))
#define Wt_fo ((bf16_t*)(ws + WS_WFO))
#define Bt3 ((bf16_t*)(ws + WS_BT3))
#define Bt1 ((bf16_t*)(ws + WS_BT1))
#define mod ((float*)(ws + WS_MOD))
#define rope ((float*)(ws + WS_ROPE))
#define lamS ((float*)(ws + WS_LAMS))
#define lamT ((float*)(ws + WS_LAMT))
#define Hb ((bf16_t*)(ws + WS_H))
#define Oatt ((bf16_t*)(ws + WS_OATT))
#define Yssm ((bf16_t*)(ws + WS_YSSM))
#define H2 ((bf16_t*)(ws + WS_H2))
#define Ug ((bf16_t*)(ws + WS_UG))
#define Sst ((float*)(ws + WS_S))
#define Vt ((bf16_t*)(ws + WS_VT))
#define tmp ((bf16_t*)(ws + WS_TMP))
#define Hid ((bf16_t*)(ws + WS_HID))
#define Qb ((bf16_t*)(ws + WS_Q))
#define Zb ((bf16_t*)(ws + WS_Z))
#define Kb ((bf16_t*)(ws + WS_K))
#define Mg ((bf16_t*)(ws + WS_MERGED))
#define SGs ((bf16_t*)(ws + WS_SGS))
#define SGa ((bf16_t*)(ws + WS_SGA))
    const int lo = args.ph_lo, hi_ph = args.ph_hi;
    volatile LAS unsigned* bst = (volatile LAS unsigned*)(lds + LDS_BYTES - 64);
    if (tid < 2) bst[tid] = 0u;
    __syncthreads();
    const XcdBarrier gbar = xcd_barrier_post((unsigned*)(ws + WS_BAR) + args.seg * XCD_BAR_WORDS, bst);
    if (args.pad == 0x7fffffff) grid.sync();
#define IN(k) (lo <= (k) && (k) < hi_ph)
#define SEAM(k) do { if (IN(k) && IN((k) + 1)) xcd_barrier(gbar); } while (0)

    if (IN(0)) {
        if (cb == 0) {
            for (int idx = tid; idx < 64 * 16; idx += NTHREADS) { const int pos = idx >> 4, f = idx & 15; const float inv = powf(10000.f, -(float)f / 16.f); const float a = (float)pos * inv; rope[idx * 2] = cosf(a); rope[idx * 2 + 1] = sinf(a); }
            if (tid == 0) { float s1 = 0.f, s2 = 0.f; for (int i = 0; i < 64; ++i) { s1 += args.in[18][i] * args.in[19][i]; s2 += args.in[20][i] * args.in[21][i]; } lamS[0] = expf(s1) - expf(s2) + 0.2f; }
        }
        {
            constexpr int T0 = 32 * 128, T1 = 16 * 16, T2 = 16 * 32, T3 = 16 * 32, T4 = 32 * 32, T5 = 32 * 176, T6 = 88 * 32;
            constexpr int NITEMS = 64 + 96 + (T0 + T1 + T2 + T3 + T4 + T5 + T6) / 8;
            LAS int* qslot = (LAS int*)(lds + LDS_BYTES - 16);
            int* ctr = (int*)(ws + WS_CTR) + args.seg * 16;
            LAS float* scr = (LAS float*)(lds + wave * 16640);
            for (;;) {
                __syncthreads();
                if (tid == 0) *qslot = atomicAdd(ctr, 1);
                __syncthreads();
                const int it = *qslot;
                if (it >= NITEMS) break;
                if (it < 64) { if (args.pad & 1) ssm_coef_item(lds, args.in, Bt3, Bt1, lamT, it); }
                else if (it < 160) { if (args.pad & 2) mod_item128(lds, args.in[1], args.in[3], args.in[4], args.in[5], mod, it - 64); }
                else if (args.pad & 4) {
                    int r = (it - 160) * 8 + wave;
                    if (r < T0) { const int nblk = 128, kb = r / nblk, nb = r % nblk; transpose_tile64(args.in[7], DM, DIN, Wt_in, nb * 64, nb * 64, kb * 64, scr, lane); }
                    else if ((r -= T0) < T1) { const int nblk = 16, kb = r / nblk, nb = r % nblk; transpose_tile64(args.in[16], 1024, 1024, Wt_glu, nb * 64, nb * 64, kb * 64, scr, lane); }
                    else if ((r -= T1) < T2) { const int nblk = 32, kb = r / nblk, nb = r % nblk; transpose_tile64(args.in[23], 2048, DM, Wt_ps, nb * 64, nb * 64, kb * 64, scr, lane); }
                    else if ((r -= T2) < T3) { const int nblk = 32, kb = r / nblk, nb = r % nblk; transpose_tile64(args.in[24], 2048, DM, Wt_ps + 1024, nb * 64, nb * 64, kb * 64, scr, lane); }
                    else if ((r -= T3) < T4) { const int nblk = 32, kb = r / nblk, nb = r % nblk; transpose_tile64(args.in[25], DM, DM, Wt_out, nb * 64, nb * 64, kb * 64, scr, lane); }
                    else if ((r -= T4) < T5) { const int nblk = 176, kb = r / nblk, nb = r % nblk; const int n0 = nb * 64, tile = n0 >> 8, within = n0 & 255;
                        const int src = within < 128 ? tile * 128 + within : DFF + tile * 128 + (within - 128);
                        transpose_tile64(args.in[27], DM, 2 * DFF, Wt_fi, n0, src, kb * 64, scr, lane); }
                    else { r -= T5; const int nblk = 32, kb = r / nblk, nb = r % nblk; transpose_tile64(args.in[28], DFF, DM, Wt_fo, nb * 64, nb * 64, kb * 64, scr, lane); }
                }
            }
        }
    }
    SEAM(0);
    if (IN(1)) {
        for (int row = gw; row < MTOT; row += NGW) {
            const float* xr = row < MLAT ? x + (size_t)row * DM : args.in[2] + (size_t)(row - MLAT) * DM;
            const float* mr = mod + (size_t)(row < MLAT ? (row >> 11) : 16) * NMOD;
            normmod_row(xr, args.in[6], mr, mr + DM, Hb + (size_t)row * DM, lane);
        }
    }
    SEAM(1);
    if (IN(2)) {
        pg8::Gemm g{Hb, Wt_in, DM, DM, DM, 0, 0};
        pg8::EpiInProj E{Ug, Qb, Kb, Vt, SGs, SGa, rope};
        { pg8::StaticOrder S; S.init(MLAT / 256, DIN / 256, 1, G, cb); pg8::gemm_phase(lds, g, S, E); }
        { pg8::CtxOrder S{G, cb}; pg8::gemm_phase(lds, g, S, E); }
    }
    SEAM(2);
    if (IN(3)) {
        pg8::Gemm g{Ug, Bt1, UK, 512, 512, (size_t)UROWS_PAD * UK, (size_t)256 * 512};
        pg8::EpiSsm1 E{Sst};
        pg8::StaticOrder S; S.init(UROWS_PAD / 256, 1, 64, G, cb); pg8::gemm_phase(lds, g, S, E);
    }
    SEAM(3);
    if (IN(4)) {
        for (int idx = cb * NTHREADS + tid; idx < NB * 64 * 2 * 64; idx += G * NTHREADS) {
            const int p = idx & 63, d = (idx >> 6) & 1, g = (idx >> 7) & 63, b = idx >> 13;
            const float lr = lamT[((g * 2 + d) * 64 + p) * 2], li = lamT[((g * 2 + d) * 64 + p) * 2 + 1];
            const float* Sg = Sst + (size_t)g * UROWS_PAD * 256 + d * 128 + p;
            bf16_t* Up = Ug + (size_t)g * (UROWS_PAD * UK) + 512 + d * 128 + p;
            float hr = 0.f, hi = 0.f;
#pragma unroll
            for (int kk = 0; kk < 8; ++kk) { const int k = d ? 7 - kk : kk; const float* sp = Sg + (size_t)(1024 + b * 8 + k) * 256; const float sr = sp[0], si = sp[64];
                const float nr = lr * hr - li * hi + sr, ni = lr * hi + li * hr + si; hr = nr; hi = ni; }
#pragma unroll 8
            for (int kk = 0; kk < 64; ++kk) { const int k = d ? 63 - kk : kk; const int row = b * 64 + k; bf16_t* up = Up + (size_t)row * UK; up[0] = f2bf1(hr); up[64] = f2bf1(hi);
                const float* sp = Sg + (size_t)row * 256; const float sr = sp[0], si = sp[64];
                const float nr = lr * hr - li * hi + sr, ni = lr * hi + li * hr + si; hr = nr; hi = ni; }
        }
        att::attn_phase(lds, Qb, Kb, Vt, Oatt, args.in[22], lamS, G, cb);
    }
    SEAM(4);
    if (IN(5)) {
        pg8::Gemm g{Ug, Bt3, UK, UK, UK, (size_t)UROWS_PAD * UK, (size_t)512 * UK};
        pg8::EpiSsm3 E{Zb};
        pg8::StaticOrder S; S.init(4, 2, 64, G, cb); pg8::gemm_phase(lds, g, S, E);
    }
    SEAM(5);
    if (IN(6)) {
        pg8::Gemm g{Zb, Wt_glu, 1024, 1024, 1024, 0, 0};
        pg8::EpiGlu E{Zb, args.in[17], Oatt};
        pg8::StaticOrder S; S.init(MLAT / 256, 4, 1, G, cb); pg8::gemm_phase(lds, g, S, E);
    }
    SEAM(6);
    if (IN(7)) {
        pg8::Gemm g{Oatt, Wt_ps, DM, DM, DM, 0, 0};
        pg8::EpiMerge E{SGs, SGa, Mg};
        pg8::StaticOrder S; S.init(MLAT / 256, 8, 1, G, cb); pg8::gemm_phase(lds, g, S, E);
    }
    SEAM(7);
    if (IN(9)) {
        pg8::Gemm g{Mg, Wt_out, DM, DM, DM, 0, 0};
        pg8::EpiResid E{x, mod + 2 * DM, out};
        pg8::StaticOrder S; S.init(MLAT / 256, 8, 1, G, cb); pg8::gemm_phase(lds, g, S, E);
    }
    SEAM(9);
    if (IN(10)) {
        int ln = threadIdx.x & 63; asm volatile("" : "+v"(ln));
        for (int row = gw; row < MLAT; row += NGW) { const float* mr = mod + (size_t)(row >> 11) * NMOD; normmod_row(out + (size_t)row * DM, args.in[26], mr + 3 * DM, mr + 4 * DM, H2 + (size_t)row * DM, ln); }
    }
    SEAM(10);
    if (IN(11)) {
        pg8::Gemm g{H2, Wt_fi, DM, DM, DM, 0, 0};
        pg8::EpiFfnIn E{Hid};
        pg8::StaticOrder S; S.init(MLAT / 256, 44, 1, G, cb); pg8::gemm_phase(lds, g, S, E);
    }
    SEAM(11);
    if (IN(12)) {
        pg8::Gemm g{Hid, Wt_fo, DFF, DFF, DFF, 0, 0};
        pg8::EpiResid E{out, mod + 5 * DM, out};
        pg8::StaticOrder S; S.init(MLAT / 256, 8, 1, G, cb); pg8::gemm_phase(lds, g, S, E);
    }
    SEAM(12);
    if (IN(13)) {
        const float* gf = args.in[29]; int ln = threadIdx.x & 63; asm volatile("" : "+v"(ln));
        for (int row = gw; row < MLAT; row += NGW) {
            float* xr = out + (size_t)row * DM; f32x4 v[8]; float ss = 0.f;
#pragma unroll
            for (int j = 0; j < 8; ++j) { v[j] = *(const f32x4*)(xr + 4 * ln + 256 * j); ss += (v[j][0] * v[j][0] + v[j][1] * v[j][1]) + (v[j][2] * v[j][2] + v[j][3] * v[j][3]); }
            const float rstd = rsqrtf(wave_sum(ss) * (1.f / DM) + 1e-6f);
#pragma unroll
            for (int j = 0; j < 8; ++j) { const int c = 4 * ln + 256 * j; const f32x4 g4 = *(const f32x4*)(gf + c); *(f32x4*)(xr + c) = v[j] * rstd * g4; }
        }
    }
#undef IN
#undef SEAM
#undef Wt_in
#undef Wt_glu
#undef Wt_ps
#undef Wt_pa
#undef Wt_out
#undef Wt_fi
#undef Wt_fo
#undef Bt3
#undef Bt1
#undef mod
#undef rope
#undef lamS
#undef lamT
#undef Hb
#undef Oatt
#undef Yssm
#undef H2
#undef Ug
#undef Sst
#undef Vt
#undef tmp
#undef Hid
#undef Qb
#undef Zb
#undef Kb
#undef Mg
#undef SGs
#undef SGa
}

#ifndef SEGMENTS
#define SEGMENTS 0, 14, 7, -1
#endif
extern "C" void kernel_launch(void* const* d_in, const int* in_sizes, int n_in, void* d_out, int out_size, void* d_ws, size_t ws_size, hipStream_t stream) {
    static int grid = 0;
    if (grid == 0) {
        if (n_in != 30 || out_size != MLAT * DM || ws_size < WS_END) { fprintf(stderr, "kernel_launch: unexpected shapes (n_in %d out %d ws %zu)\n", n_in, out_size, ws_size); grid = -1; return; }
        int dev = 0, cus = 0, per_cu = 0;
        (void)hipGetDevice(&dev);
        (void)hipDeviceGetAttribute(&cus, hipDeviceAttributeMultiprocessorCount, dev);
        if (hipFuncSetAttribute((const void*)fwd_kernel, hipFuncAttributeMaxDynamicSharedMemorySize, LDS_BYTES) != hipSuccess) { fprintf(stderr, "kernel_launch: hipFuncSetAttribute failed\n"); grid = -1; return; }
        if (hipOccupancyMaxActiveBlocksPerMultiprocessor(&per_cu, (const void*)fwd_kernel, NTHREADS, LDS_BYTES) != hipSuccess || per_cu < 1) { fprintf(stderr, "kernel_launch: occupancy query says %d\n", per_cu); per_cu = 1; }
        (void)hipGetLastError();
        grid = cus * per_cu;
        fprintf(stderr, "kernel_launch: grid %d (cus %d x %d)\n", grid, cus, per_cu);
    }
    if (grid < 0) return;
    Args a{};
    for (int i = 0; i < 30; ++i) a.in[i] = (const float*)d_in[i];
    a.out = (float*)d_out; a.ws = (unsigned char*)d_ws;
    (void)hipMemsetAsync((unsigned char*)d_ws + WS_CTR, 0, CTL_ZERO_BYTES, stream);
    const int segs[] = {SEGMENTS};
    for (int si = 0; si + 2 < (int)(sizeof(segs) / sizeof(int)); si += 3) {
        a.ph_lo = segs[si]; a.ph_hi = segs[si + 1]; a.seg = si / 3; a.pad = segs[si + 2];
        void* kargs[] = {&a};
        hipError_t e = hipLaunchCooperativeKernel((const void*)fwd_kernel, dim3(grid), dim3(NTHREADS), kargs, LDS_BYTES, stream);
        if (e != hipSuccess) fprintf(stderr, "kernel_launch: cooperative launch failed: %s (grid %d)\n", hipGetErrorString(e), grid);
    }
}
```
